# Optimizing an MI355X kernel written in HIP

```python
import jax, jax.numpy as jnp
from jax import lax
import numpy as np

D_MODEL = 2048
BATCH = 2
SEQ = 4096
DEPTH = 2

GRID_W = 64
CTX_LEN = 256
MIX_WIDTH = D_MODEL
FNET_WIDTH = MIX_WIDTH // 2
FNET_GROUPS = 4
FNET_GROUP_DIM = FNET_WIDTH // FNET_GROUPS
GMLP_WIDTH = MIX_WIDTH - FNET_WIDTH
GMLP_HEADS = 8
GMLP_HEAD_DIM = GMLP_WIDTH // GMLP_HEADS
GMLP_CHUNK = 128
AB_COLS = FNET_WIDTH + 2 * GMLP_WIDTH
HGRN_WIDTH = MIX_WIDTH // 2
HGRN_EXPAND = 128
HGRN_HEADS = HGRN_WIDTH // HGRN_EXPAND
HGRN_KEY = HGRN_HEADS * HGRN_EXPAND
HGRN_CHUNK = 32
HGRN_COLS = 3 * HGRN_KEY + 2 * HGRN_WIDTH
LRU_WIDTH = MIX_WIDTH - HGRN_WIDTH
LRU_HEADS = 8
LRU_HEAD_DIM = LRU_WIDTH // LRU_HEADS
LRU_CONV = 4
LRU_C = 8.0
CD_COLS = HGRN_COLS + 2 * LRU_WIDTH
N_EXPERTS = 32
TOP_K = 4
D_EXPERT = D_MODEL // 2
SWIGLU_LIMIT = 7.0
SWIGLU_ALPHA = 1.702
MOE_BLOCK = 128
EPS = 1e-6
N_EVEN = (DEPTH + 1) // 2
N_ODD = DEPTH // 2

kernel_name = "hybrid_fnet_gmlp_hgrn2_rglru_moe_dit"


def rmsnorm(x, g):
    xf = x.astype(jnp.float32)
    y = xf * lax.rsqrt(jnp.mean(xf * xf, axis=-1, keepdims=True) + EPS)
    return (y * g.astype(jnp.float32)).astype(x.dtype)


def modulate(h, shift, scale):
    return h * (1 + scale) + shift


def fourier_mix(a):
    b, l, _ = a.shape
    ag = a.reshape(b, l, FNET_GROUPS, FNET_GROUP_DIM).astype(jnp.float32)
    y = jnp.fft.fft2(ag, axes=(1, 3), norm="ortho").real
    return y.reshape(b, l, FNET_WIDTH).astype(a.dtype)


def chunk_gmlp(uv, v_g, w_s, b_s):
    b, l, _ = uv.shape
    z = jax.nn.gelu(uv)
    u, v = jnp.split(z, 2, axis=-1)
    vf = v.astype(jnp.float32)
    mu = jnp.mean(vf, axis=-1, keepdims=True)
    var = jnp.mean(jnp.square(vf - mu), axis=-1, keepdims=True)
    v = ((vf - mu) * lax.rsqrt(var + EPS) * v_g).astype(uv.dtype)
    n = l // GMLP_CHUNK
    vc = v.reshape(b, n, GMLP_CHUNK, GMLP_HEADS, GMLP_HEAD_DIM)
    s = jnp.einsum('hpq,bnqhd->bnphd', w_s, vc) + b_s.T[:, :, None]
    return u * s.reshape(b, l, GMLP_WIDTH)


def ab_mix(p, v_g, w_s, b_s):
    a = fourier_mix(p[..., :FNET_WIDTH])
    g = chunk_gmlp(p[..., FNET_WIDTH:], v_g, w_s, b_s)
    return jnp.concatenate([a, g], axis=-1)


def hgrn_chunk_scan(q, k, v, logf, s0):
    b, h, l, _ = q.shape
    dv = v.shape[-1]
    n = l // HGRN_CHUNK
    blocks = lambda t: t.reshape(b, h, n, HGRN_CHUNK, t.shape[-1])
    q, k, v, logf = blocks(q), blocks(k), blocks(v), blocks(logf)
    cum = jnp.cumsum(logf, axis=3)
    q_dec = q * jnp.exp(cum)
    k_inv = k * jnp.exp(-cum)
    k_end = k * jnp.exp(cum[..., -1:, :] - cum)
    mask = jnp.tril(jnp.ones((HGRN_CHUNK, HGRN_CHUNK), dtype=bool))
    scores = jnp.where(mask, jnp.einsum('bhnik,bhnjk->bhnij', q_dec, k_inv), 0.0)
    intra = jnp.einsum('bhnij,bhnjv->bhniv', scores, v)
    decay_end = jnp.exp(cum[..., -1, :])

    def step(s, inp):
        qd, ke, vc, de = inp
        out = jnp.einsum('bhik,bhkv->bhiv', qd, s)
        s = s * de[..., None] + jnp.einsum('bhik,bhiv->bhkv', ke, vc)
        return s, out

    xs = tuple(jnp.moveaxis(t, 2, 0) for t in (q_dec, k_end, v, decay_end))
    s_final, inter = lax.scan(step, s0, xs)
    o = intra + jnp.moveaxis(inter, 0, 2)
    return o.reshape(b, h, l, dv), s_final


def hgrn_dir(q, k, v, logf, reverse, s0):
    flip = (lambda t: jnp.flip(t, axis=2)) if reverse else (lambda t: t)
    o, s = hgrn_chunk_scan(flip(q), flip(k), flip(v), flip(logf), s0)
    return flip(o), s


def hgrn_inputs(p, lb):
    b, l, _ = p.shape
    q, f_fw, f_bw, i, g = jnp.split(p.astype(jnp.float32),
                                    [HGRN_KEY, 2 * HGRN_KEY, 3 * HGRN_KEY, 3 * HGRN_KEY + HGRN_WIDTH], axis=-1)
    heads = lambda t: t.reshape(b, l, HGRN_HEADS, -1).transpose(0, 2, 1, 3)

    def forget(fr):
        f = lb + (1 - lb) * jax.nn.sigmoid(fr)
        return heads(jnp.log(f)), heads((1 - lb) * jax.nn.sigmoid(-fr))

    return heads(jax.nn.silu(q)), heads(i), forget(f_fw), forget(f_bw), g


def hgrn_readout(o, g, onorm_g, dtype):
    b, h, l, dv = o.shape
    o = o * lax.rsqrt(jnp.mean(o * o, axis=-1, keepdims=True) + EPS)
    o = o.transpose(0, 2, 1, 3).reshape(b, l, h * dv) * onorm_g.astype(jnp.float32)
    return (o * jax.nn.silu(g)).astype(dtype)


def hgrn_mix(p_lat, p_ctx, lb, onorm_g, need_ctx):
    q_l, v_l, (lf_fl, k_fl), (lf_bl, k_bl), g_l = hgrn_inputs(p_lat, lb)
    q_c, v_c, (lf_fc, k_fc), (lf_bc, k_bc), g_c = hgrn_inputs(p_ctx, lb)
    s0 = jnp.zeros((p_lat.shape[0], HGRN_HEADS, HGRN_EXPAND, HGRN_WIDTH // HGRN_HEADS), jnp.float32)
    oc_f, sc_f = hgrn_dir(q_c, k_fc, v_c, lf_fc, False, s0)
    oc_b, sc_b = hgrn_dir(q_c, k_bc, v_c, lf_bc, True, s0)
    ol_f, _ = hgrn_dir(q_l, k_fl, v_l, lf_fl, False, sc_f)
    ol_b, _ = hgrn_dir(q_l, k_bl, v_l, lf_bl, True, sc_b)
    out_l = hgrn_readout(ol_f + ol_b, g_l, onorm_g, p_lat.dtype)
    out_c = hgrn_readout(oc_f + oc_b, g_c, onorm_g, p_ctx.dtype) if need_ctx else None
    return out_l, out_c


def short_conv(x, w, bias):
    l = x.shape[1]
    left = LRU_CONV // 2
    xp = jnp.pad(x, ((0, 0), (left, LRU_CONV - 1 - left), (0, 0)))
    y = xp[:, 0:l] * w[0]
    for j in range(1, LRU_CONV):
        y = y + xp[:, j:j + l] * w[j]
    return y + bias


def blockdiag(x, w):
    b, l, _ = x.shape
    xh = x.reshape(b, l, LRU_HEADS, LRU_HEAD_DIM)
    return jnp.einsum('blhi,hij->blhj', xh, w).reshape(b, l, LRU_WIDTH)


def lru_coeffs(xc, w_r, b_r, w_i, b_i, lam):
    xf = xc.astype(jnp.float32)
    r = jax.nn.sigmoid(blockdiag(xf, w_r.astype(jnp.float32)) + b_r)
    i = jax.nn.sigmoid(blockdiag(xf, w_i.astype(jnp.float32)) + b_i)
    log_a = -LRU_C * r * jax.nn.softplus(-lam.astype(jnp.float32))
    return jnp.exp(log_a), jnp.sqrt(-jnp.expm1(2 * log_a)) * (i * xf)


def linear_scan(a, u, h0, reverse):
    if reverse:
        a, u = jnp.flip(a, axis=1), jnp.flip(u, axis=1)
    u = u.at[:, 0].add(a[:, 0] * h0)
    combine = lambda e, f: (e[0] * f[0], f[0] * e[1] + f[1])
    _, h = lax.associative_scan(combine, (a, u), axis=1)
    last = h[:, -1]
    if reverse:
        h = jnp.flip(h, axis=1)
    return h, last


def lru_mix(p_lat, p_ctx, conv_w, conv_b, w_r, b_r, w_i, b_i, lam, need_ctx):
    gate_l, x_l = jnp.split(p_lat, 2, axis=-1)
    gate_c, x_c = jnp.split(p_ctx, 2, axis=-1)
    x_l = short_conv(x_l, conv_w, conv_b)
    x_c = short_conv(x_c, conv_w, conv_b)
    h0 = jnp.zeros((p_lat.shape[0], LRU_WIDTH), jnp.float32)
    hs_l, hs_c = [], []
    for direction in range(2):
        rev = direction == 1
        a_c, u_c = lru_coeffs(x_c, w_r[direction], b_r[direction], w_i[direction], b_i[direction], lam[direction])
        h_c, last_c = linear_scan(a_c, u_c, h0, rev)
        a_l, u_l = lru_coeffs(x_l, w_r[direction], b_r[direction], w_i[direction], b_i[direction], lam[direction])
        h_l, _ = linear_scan(a_l, u_l, last_c, rev)
        hs_l.append(h_l)
        hs_c.append(h_c)
    out_l = ((hs_l[0] + hs_l[1]) * jax.nn.gelu(gate_l.astype(jnp.float32))).astype(p_lat.dtype)
    out_c = ((hs_c[0] + hs_c[1]) * jax.nn.gelu(gate_c.astype(jnp.float32))).astype(p_ctx.dtype) if need_ctx else None
    return out_l, out_c


def moe(h, w_router, b_router, w_gu, b_gu, w_down, b_down):
    t, d = h.shape
    logits = (h @ w_router + b_router).astype(jnp.float32)
    top_v, top_e = lax.top_k(logits, TOP_K)
    probs = jax.nn.softmax(top_v, axis=-1)
    flat_e = top_e.reshape(-1)
    tk = t * TOP_K
    order = jnp.argsort(flat_e)
    sorted_e = flat_e[order]
    counts = jnp.zeros((N_EXPERTS,), jnp.int32).at[flat_e].add(1)
    starts = jnp.cumsum(counts) - counts
    padded = (counts + MOE_BLOCK - 1) // MOE_BLOCK * MOE_BLOCK
    pend = jnp.cumsum(padded)
    pstart = pend - padded
    dest = pstart[sorted_e] + (jnp.arange(tk, dtype=jnp.int32) - starts[sorted_e])
    n_blocks = -(-(tk + N_EXPERTS * (MOE_BLOCK - 1)) // MOE_BLOCK)
    n_slots = n_blocks * MOE_BLOCK
    slot_tok = jnp.full((n_slots,), t, jnp.int32).at[dest].set((order // TOP_K).astype(jnp.int32))
    slot_w = jnp.zeros((n_slots,), jnp.float32).at[dest].set(probs.reshape(-1)[order])
    block_e = jnp.minimum(jnp.searchsorted(pend, jnp.arange(n_blocks, dtype=jnp.int32) * MOE_BLOCK, side='right'),
                          N_EXPERTS - 1)
    h_pad = jnp.concatenate([h, jnp.zeros((1, d), h.dtype)], axis=0)
    xb = h_pad[slot_tok].reshape(n_blocks, MOE_BLOCK, d)

    def expert_block(args):
        xblk, e = args
        gu = xblk @ w_gu[e] + b_gu[e]
        gate = jnp.minimum(gu[:, :D_EXPERT], SWIGLU_LIMIT)
        up = jnp.clip(gu[:, D_EXPERT:], -SWIGLU_LIMIT, SWIGLU_LIMIT)
        act = gate * jax.nn.sigmoid(SWIGLU_ALPHA * gate) * (up + 1)
        return act @ w_down[e] + b_down[e]

    yb = lax.map(expert_block, (xb, block_e)).reshape(n_slots, d)
    out = jnp.zeros((t + 1, d), yb.dtype).at[slot_tok].add(yb * slot_w[:, None].astype(yb.dtype))
    return out[:t]


def setup_inputs(seed: int = 0) -> dict:
    key = jax.random.key(seed)
    ks = jax.random.split(key, 32)
    nrm = lambda k, shape, s: jax.random.normal(k, shape, jnp.float32) * s
    D = D_MODEL
    a_c = jax.random.uniform(ks[22], (N_ODD, 2, LRU_WIDTH), jnp.float32, minval=0.9, maxval=0.999)
    a = a_c ** (1.0 / LRU_C)
    return {
        "x": nrm(ks[0], (BATCH, SEQ, D), 1.0),
        "c": nrm(ks[1], (BATCH, D), 1.0),
        "ctx": nrm(ks[2], (BATCH, CTX_LEN, D), 1.0),
        "c_ctx": nrm(ks[3], (D,), 1.0),
        "mod_w": nrm(ks[4], (DEPTH, D, 6 * D), 0.5 * D ** -0.5),
        "mod_b": nrm(ks[5], (DEPTH, 6 * D), 0.02),
        "norm_g": 1.0 + nrm(ks[6], (DEPTH, 4, D), 0.02),
        "ab_w_in": nrm(ks[7], (N_EVEN, D, AB_COLS), D ** -0.5),
        "ab_w_out": nrm(ks[8], (N_EVEN, MIX_WIDTH, D), MIX_WIDTH ** -0.5),
        "gmlp_v_g": 1.0 + nrm(ks[9], (N_EVEN, GMLP_WIDTH), 0.02),
        "gmlp_ws": nrm(ks[10], (N_EVEN, GMLP_HEADS, GMLP_CHUNK, GMLP_CHUNK), GMLP_CHUNK ** -0.5),
        "gmlp_bs": 1.0 + nrm(ks[11], (N_EVEN, GMLP_HEADS, GMLP_CHUNK), 0.02),
        "cd_w_in": nrm(ks[12], (N_ODD, D, CD_COLS), D ** -0.5),
        "cd_w_out": nrm(ks[13], (N_ODD, MIX_WIDTH, D), MIX_WIDTH ** -0.5),
        "hgrn_lb": nrm(ks[14], (DEPTH, HGRN_KEY), 0.1),
        "hgrn_onorm_g": 1.0 + nrm(ks[15], (N_ODD, HGRN_WIDTH), 0.02),
        "lru_conv_w": nrm(ks[16], (N_ODD, LRU_CONV, LRU_WIDTH), LRU_CONV ** -0.5),
        "lru_conv_b": nrm(ks[17], (N_ODD, LRU_WIDTH), 0.02),
        "lru_wr": nrm(ks[18], (N_ODD, 2, LRU_HEADS, LRU_HEAD_DIM, LRU_HEAD_DIM), LRU_HEAD_DIM ** -0.5),
        "lru_br": nrm(ks[19], (N_ODD, 2, LRU_WIDTH), 0.02),
        "lru_wi": nrm(ks[20], (N_ODD, 2, LRU_HEADS, LRU_HEAD_DIM, LRU_HEAD_DIM), LRU_HEAD_DIM ** -0.5),
        "lru_bi": nrm(ks[21], (N_ODD, 2, LRU_WIDTH), 0.02),
        "lru_lambda": jnp.log(a) - jnp.log1p(-a),
        "router_w": nrm(ks[23], (DEPTH, D, N_EXPERTS), D ** -0.5),
        "router_b": nrm(ks[24], (DEPTH, N_EXPERTS), 0.01),
        "exp_w_gu": nrm(ks[25], (DEPTH, N_EXPERTS, D, 2 * D_EXPERT), D ** -0.5),
        "exp_b_gu": nrm(ks[26], (DEPTH, N_EXPERTS, 2 * D_EXPERT), 0.02),
        "exp_w_down": nrm(ks[27], (DEPTH, N_EXPERTS, D_EXPERT, D), D_EXPERT ** -0.5),
        "exp_b_down": nrm(ks[28], (DEPTH, N_EXPERTS, D), 0.02),
    }


def reference(x, c, ctx, c_ctx, mod_w, mod_b, norm_g, ab_w_in, ab_w_out, gmlp_v_g, gmlp_ws, gmlp_bs,
              cd_w_in, cd_w_out, hgrn_lb, hgrn_onorm_g, lru_conv_w, lru_conv_b, lru_wr, lru_br, lru_wi, lru_bi,
              lru_lambda, router_w, router_b, exp_w_gu, exp_b_gu, exp_w_down, exp_b_down):
    b, l, d = x.shape
    n_lat = b * l
    lb_soft = jax.nn.softmax(hgrn_lb.astype(jnp.float32), axis=0)
    lb_all = jnp.cumsum(lb_soft, axis=0) - lb_soft[0]
    cond_l = jax.nn.silu(c)[:, None, :]
    cond_c = jax.nn.silu(c_ctx)[None, None, :]
    xl, xc = x, ctx
    for layer in range(DEPTH):
        last = layer == DEPTH - 1
        odd = layer % 2 == 1
        j = layer // 2
        use_ctx = (not last) or odd
        sh1, sc1, ga1, sh2, sc2, ga2 = jnp.split(cond_l @ mod_w[layer] + mod_b[layer], 6, axis=-1)
        hl = modulate(rmsnorm(xl, norm_g[layer, 0]), sh1, sc1)
        if use_ctx:
            csh1, csc1, cga1, csh2, csc2, cga2 = jnp.split(cond_c @ mod_w[layer] + mod_b[layer], 6, axis=-1)
            hc = modulate(rmsnorm(xc, norm_g[layer, 0]), csh1, csc1)
        if not odd:
            w_out = ab_w_out[j]
            mix_l = ab_mix(hl @ ab_w_in[j], gmlp_v_g[j], gmlp_ws[j], gmlp_bs[j])
            mix_c = None if last else ab_mix(hc @ ab_w_in[j], gmlp_v_g[j], gmlp_ws[j], gmlp_bs[j])
        else:
            w_out = cd_w_out[j]
            pl = hl @ cd_w_in[j]
            pc = hc @ cd_w_in[j]
            hg_l, hg_c = hgrn_mix(pl[..., :HGRN_COLS], pc[..., :HGRN_COLS], lb_all[layer], hgrn_onorm_g[j], not last)
            lr_l, lr_c = lru_mix(pl[..., HGRN_COLS:], pc[..., HGRN_COLS:], lru_conv_w[j], lru_conv_b[j],
                                 lru_wr[j], lru_br[j], lru_wi[j], lru_bi[j], lru_lambda[j], not last)
            mix_l = jnp.concatenate([hg_l, lr_l], axis=-1)
            mix_c = None if last else jnp.concatenate([hg_c, lr_c], axis=-1)
        xl = xl + ga1 * rmsnorm(mix_l @ w_out, norm_g[layer, 1])
        hl2 = modulate(rmsnorm(xl, norm_g[layer, 2]), sh2, sc2).reshape(n_lat, d)
        moe_args = (router_w[layer], router_b[layer], exp_w_gu[layer], exp_b_gu[layer],
                    exp_w_down[layer], exp_b_down[layer])
        if last:
            y = moe(hl2, *moe_args)
        else:
            xc = xc + cga1 * rmsnorm(mix_c @ w_out, norm_g[layer, 1])
            hc2 = modulate(rmsnorm(xc, norm_g[layer, 2]), csh2, csc2)
            y = moe(jnp.concatenate([hl2, hc2.reshape(-1, d)], axis=0), *moe_args)
            xc = xc + cga2 * rmsnorm(y[n_lat:].reshape(xc.shape), norm_g[layer, 3])
        xl = xl + ga2 * rmsnorm(y[:n_lat].reshape(b, l, d), norm_g[layer, 3])
    return xl
```

```cpp
#include <hip/hip_runtime.h>
#include <cstdio>
#include <cstdint>

#define LAS __attribute__((address_space(3)))
typedef unsigned short bf16_t;
typedef short bf16x8 __attribute__((ext_vector_type(8)));
typedef float f32x4 __attribute__((ext_vector_type(4)));
typedef float f32x2 __attribute__((ext_vector_type(2)));
typedef unsigned u32x4 __attribute__((ext_vector_type(4)));
typedef unsigned u32x2 __attribute__((ext_vector_type(2)));

constexpr int D = 2048, NB = 2, SEQ = 4096, CTXL = 256, NLAT = NB * SEQ, NCTX = NB * CTXL, NTOK = NLAT + NCTX;
constexpr int NE = 32, DE = 1024, LCAP = NTOK;
constexpr int AB_COLS = 3072, CD_COLS = 7168;
constexpr int MAXTILES = 168, NSLOT = MAXTILES * 256;
constexpr float EPS = 1e-6f;
constexpr int NWAVES = 8, NTHR = 512;
constexpr int LDS_STAGE = 131072, MISC_OFF = 145408, LDS_BYTES = 147456;
constexpr int NPH = 20;
constexpr int KSPLIT = 16;

constexpr size_t al256(size_t x) { return (x + 255) & ~(size_t)255; }
constexpr size_t WS_CTL = 0, CTL_BYTES = 65536;
constexpr size_t WS_MODP = WS_CTL + CTL_BYTES;
constexpr size_t WS_MODV = WS_MODP + al256((size_t)KSPLIT * 2 * 3 * 6 * D * 4);
constexpr size_t WS_WABIN = WS_MODV + al256((size_t)2 * 3 * 6 * D * 4);
constexpr size_t WS_WOUT = WS_WABIN + (size_t)AB_COLS * D * 2;
constexpr size_t WS_WCDIN = WS_WOUT + (size_t)2 * D * D * 2;
constexpr size_t WS_WGU = WS_WCDIN + (size_t)CD_COLS * D * 2;
constexpr size_t WS_WDN = WS_WGU + (size_t)2 * NE * 2048 * D * 2;
constexpr size_t WS_FA = WS_WDN + (size_t)2 * NE * D * DE * 2;
constexpr size_t WS_GC = WS_FA + (size_t)128 * 128 * 2;
constexpr size_t WS_DLC = WS_GC + (size_t)64 * 128 * 2;
constexpr size_t WS_F256 = WS_DLC + (size_t)256 * 512 * 2;
constexpr size_t WS_XL = WS_F256 + (size_t)512 * 256 * 2;
constexpr size_t WS_H = WS_XL + (size_t)NTOK * D * 4;
constexpr size_t WS_PA = WS_H + (size_t)NTOK * D * 2;
constexpr size_t WS_PZ = WS_PA + (size_t)NTOK * 1024 * 2;
constexpr size_t WS_ZT = WS_PZ + (size_t)NTOK * 2048 * 2;
constexpr size_t WS_ZTC = WS_ZT + (size_t)2 * 1024 * 2 * 4096 * 2;
constexpr size_t WS_MIX = WS_ZTC + (size_t)2 * 1024 * 2 * 256 * 2;
constexpr size_t WS_O = WS_MIX + (size_t)NTOK * D * 2;
constexpr size_t WS_TOKE = WS_O + (size_t)NTOK * D * 2;
constexpr size_t WS_TOKR = WS_TOKE + al256((size_t)NTOK * 4 * 4);
constexpr size_t WS_TOKP = WS_TOKR + al256((size_t)NTOK * 4 * 4);
constexpr size_t WS_LIST = WS_TOKP + al256((size_t)NTOK * 4 * 4);
constexpr size_t WS_ACT = WS_LIST + al256((size_t)NE * LCAP * 4);
constexpr size_t WS_YS = WS_ACT + (size_t)NSLOT * DE * 2;
constexpr size_t WS_H2 = WS_YS + (size_t)NSLOT * D * 2;
constexpr size_t WS_Q = WS_H2 + (size_t)NTOK * D * 2;
constexpr size_t WS_LF = WS_Q + (size_t)NTOK * 1024 * 2;
constexpr size_t WS_V = WS_LF + (size_t)NTOK * 2048 * 4;
constexpr size_t WS_G = WS_V + (size_t)NTOK * 1024 * 2;
constexpr size_t WS_LG = WS_G + (size_t)NTOK * 1024 * 2;
constexpr size_t WS_LX = WS_LG + (size_t)NTOK * 1024 * 2;
constexpr size_t WS_LA = WS_LX + (size_t)NTOK * 1024 * 2;
constexpr size_t WS_LU = WS_LA + (size_t)2 * NTOK * 1024 * 4;
constexpr size_t WS_OD = WS_LU + (size_t)2 * NTOK * 1024 * 4;
constexpr size_t WS_HS = WS_OD + (size_t)2 * NLAT * 1024 * 4;
constexpr size_t WS_ST = WS_HS + (size_t)2 * NLAT * 1024 * 4;
constexpr size_t WS_DT = WS_ST + (size_t)32 * 16 * 128 * 128 * 4;
constexpr size_t WS_ST2 = WS_DT + (size_t)32 * 16 * 128 * 4;
constexpr size_t WS_WRT = WS_ST2 + (size_t)32 * 16 * 128 * 128 * 4;
constexpr size_t WS_PS = WS_WRT + (size_t)2 * 2 * 8 * 128 * 128 * 2;
constexpr size_t WS_ES = WS_PS + (size_t)2 * 136 * 1024 * 4;
constexpr size_t WS_HI = WS_ES + (size_t)2 * 136 * 1024 * 4;
constexpr size_t WS_GST = WS_HI + (size_t)2 * 136 * 1024 * 4;
constexpr size_t WS_RWH = WS_GST + (size_t)NTOK * 2 * 4;
constexpr size_t WS_RWL = WS_RWH + (size_t)2 * 32 * 2048 * 2;
constexpr size_t WS_RGN1 = WS_RWL + (size_t)2 * 32 * 2048 * 2;
constexpr size_t WS_END = WS_RGN1 + (WS_Q - WS_H);
__host__ __device__ constexpr size_t LOFF(int layer) { return layer ? (WS_RGN1 - WS_H) : 0; }

#define XB_TMO      128
#define XB_XCNT(j)  (256  + 64 * (j))
#define XB_XSUB(j)  (1280 + 64 * (j))
#define XB_XGEN(j)  (2304 + 64 * (j))
#define XB_TOP      3328
#define XB_TOPGEN   3392
#define XCD_BAR_WORDS 3456
#define XB_SPIN_CAP (1u << 22)
constexpr int CW_BAR = 0, CW_CNT = 4096, CNT_STRIDE = 32;

__device__ __forceinline__ unsigned xb_ld(unsigned* p)              { return __hip_atomic_load(p, __ATOMIC_RELAXED, __HIP_MEMORY_SCOPE_AGENT); }
__device__ __forceinline__ unsigned xb_add(unsigned* p, unsigned v) { return __hip_atomic_fetch_add(p, v, __ATOMIC_RELAXED, __HIP_MEMORY_SCOPE_AGENT); }
__device__ __forceinline__ unsigned xb_xcc_id() { return (unsigned)__builtin_amdgcn_s_getreg((3 << 11) | 20) & 0xFu; }
#define XB_SPIN(cond, bar) do { unsigned _sp = 0; while (cond) { __builtin_amdgcn_s_sleep(1); \
    if ((++_sp & 255u) == 0u) { if (xb_ld(&(bar)[XB_TMO])) break; if (_sp > XB_SPIN_CAP) { atomicAdd(&(bar)[XB_TMO], 1u); break; } } } } while (0)
struct XcdBarrier { unsigned* bar; unsigned x; volatile LAS unsigned* st; };
__device__ __forceinline__ XcdBarrier xcd_barrier_post(unsigned* bar, volatile LAS unsigned* st) {
    XcdBarrier b; b.bar = bar; b.x = xb_xcc_id(); b.st = st;
    if (threadIdx.x == 0) (void)xb_add(&bar[XB_XCNT(b.x)], 1u);
    return b;
}
__device__ __forceinline__ void xcd_barrier_complete(unsigned* bar, unsigned x, unsigned& nloc, unsigned& nx) {
    const unsigned G = gridDim.x * gridDim.y * gridDim.z;
    unsigned sum, cnt, mine, sp = 0u;
    for (;;) {
        sum = 0u; cnt = 0u; mine = 0u;
#pragma unroll
        for (unsigned j = 0; j < 16; ++j) { const unsigned c = xb_ld(&bar[XB_XCNT(j)]); sum += c; cnt += (c > 0u) ? 1u : 0u; mine = (j == x) ? c : mine; }
        if (sum == G) break;
        __builtin_amdgcn_s_sleep(1);
        if ((++sp & 255u) == 0u) { if (xb_ld(&bar[XB_TMO])) break; if (sp > XB_SPIN_CAP) { atomicAdd(&bar[XB_TMO], 1u); break; } }
    }
    nloc = mine > 0u ? mine : 1u; nx = cnt > 0u ? cnt : 1u;
}
__device__ __forceinline__ void xcd_barrier(const XcdBarrier& b) {
    asm volatile("s_waitcnt vmcnt(0)" ::: "memory");
    __syncthreads();
    if (threadIdx.x == 0) {
        unsigned* bar = b.bar;
        __builtin_amdgcn_s_waitcnt(0);
        unsigned nloc = b.st[0], nx = b.st[1];
        if (nloc == 0u) { xcd_barrier_complete(bar, b.x, nloc, nx); b.st[0] = nloc; b.st[1] = nx; }
        const unsigned old = xb_add(&bar[XB_XSUB(b.x)], 1u);
        const unsigned gen = old / nloc;
        if (old + 1u == (gen + 1u) * nloc) {
            __builtin_amdgcn_fence(__ATOMIC_RELEASE, "agent");
            asm volatile("s_waitcnt vmcnt(0)" ::: "memory");
            const unsigned og = xb_add(&bar[XB_TOP], 1u);
            const unsigned tg = og / nx;
            if (og + 1u == (tg + 1u) * nx) xb_add(&bar[XB_TOPGEN], 1u);
            else XB_SPIN(xb_ld(&bar[XB_TOPGEN]) == tg, bar);
            __builtin_amdgcn_fence(__ATOMIC_ACQUIRE, "agent");
            xb_add(&bar[XB_XGEN(b.x)], 1u);
            asm volatile("s_waitcnt vmcnt(0)" ::: "memory");
        } else {
            XB_SPIN(xb_ld(&bar[XB_XGEN(b.x)]) == gen, bar);
            __builtin_amdgcn_fence(__ATOMIC_ACQUIRE, "agent");
            asm volatile("s_waitcnt vmcnt(0)" ::: "memory");
        }
    }
    __syncthreads();
}

typedef __bf16 bf16x2_t __attribute__((ext_vector_type(2)));
__device__ __forceinline__ unsigned pk2(float lo, float hi) { const f32x2 v = {lo, hi}; return __builtin_bit_cast(unsigned, __builtin_convertvector(v, bf16x2_t)); }
__device__ __forceinline__ float bflo(unsigned w) { return __uint_as_float(w << 16); }
__device__ __forceinline__ float bfhi(unsigned w) { return __uint_as_float(w & 0xffff0000u); }
__device__ __forceinline__ float bf1(bf16_t b) { return __uint_as_float((unsigned)b << 16); }
__device__ __forceinline__ float wave_sum(float v) {
#pragma unroll
    for (int o = 1; o < 64; o <<= 1) v += __shfl_xor(v, o);
    return v;
}
__device__ __forceinline__ float rdl(float v, int l) { return __uint_as_float((unsigned)__builtin_amdgcn_readlane((int)__float_as_uint(v), l)); }
__device__ __forceinline__ float sigmoidf_(float x) { return __builtin_amdgcn_rcpf(1.0f + __expf(-x)); }
__device__ __forceinline__ float siluf_(float x) { return x * sigmoidf_(x); }
__device__ __forceinline__ float gelu_tanh(float x) { const float y = 1.5957691216057308f * (x + 0.044715f * x * x * x); return x * sigmoidf_(y); }

namespace pg8 {
constexpr int BM = 256, BK = 64, HALF = 128, HTB = HALF * BK * 2, STAGE_BYTES = 8 * HTB;
__device__ __forceinline__ int lds_byte(int r, int c) { const int st = (r >> 4) * 2 + (c >> 5), rr = r & 15, cc = c & 31, ob = rr * 64 + cc * 2; return st * 1024 + (ob ^ (((ob >> 9) & 1) << 5)); }
__device__ __forceinline__ void stage_rc(int b, int& R, int& C) { const int st = b / 1024, sb = b % 1024, swz = sb ^ (((sb >> 9) & 1) << 5); R = (st >> 1) * 16 + swz / 64; C = (st & 1) * 32 + (swz % 64) / 2; }
__device__ __forceinline__ int perm32(int rho) { const int n = rho >> 4, i = rho & 15; return 8 * (i >> 2) + 4 * n + (i & 3); }
struct LanePos { int R[2], C[2]; };
template <bool GATHER> struct UnitAO { unsigned ao[2][2]; };
template <> struct UnitAO<false> {};
template <bool GATHER> struct Unit : UnitAO<GATHER> {
    unsigned a0, a1, b0, b1;
    int nt;
    int full;
    int p0, p1, p2;
};
template <bool GATHER> __device__ __forceinline__ unsigned unit_ao(const Unit<GATHER>& u, int h, int i, const unsigned (&voffA)[2]) { if constexpr (GATHER) return u.ao[h][i]; else return voffA[i]; }
template <class Epi, class Sched, bool GATHER>
__device__ __forceinline__ void gemm_phase(LAS unsigned char* lds, const Sched& S, const Epi& E, int tid_in) {
    int tid = tid_in; asm volatile("" : "+v"(tid));
    const int wid = __builtin_amdgcn_readfirstlane(tid >> 6), lane = tid & 63, wr = wid >> 2, wc = wid & 3, fr = lane & 15, fq = lane >> 4;
    LanePos lp; unsigned voffB[2], voffA[2];
#pragma unroll
    for (int i = 0; i < 2; ++i) { int R, C; stage_rc(tid * 16 + i * 8192, R, C); lp.R[i] = R; lp.C[i] = C; const int Rb = (R & ~31) + perm32(R & 31); voffB[i] = (unsigned)(S.brow(Rb) * S.ldb + C) * 2u; voffA[i] = (unsigned)(R * S.lda + C) * 2u; }
    const unsigned kstep = (unsigned)(BK * 2); constexpr unsigned kstepB = Sched::KSTEPB, kstepA = Sched::KSTEPA;
    const unsigned ldsw = (unsigned)wid * 1024u;
    const int aoff = lds_byte(wr * 64 + fr, fq * 8), boff = lds_byte(wc * 32 + fr, fq * 8);
    const char* const Abase = S.Abase; const char* const Bbase = S.Bbase;
#define PG8_SA(b, h) (((b) * 2 + (h)) * HTB)
#define PG8_SB(b, h) ((4 + (b) * 2 + (h)) * HTB)
#define PG8_STAGE(bufoff, gbase, o0, o1, aux) do { \
        __builtin_amdgcn_global_load_lds((const unsigned*)((gbase) + (o0)), (LAS unsigned*)(lds + (bufoff) + ldsw), 16, 0, aux); \
        __builtin_amdgcn_global_load_lds((const unsigned*)((gbase) + (o1)), (LAS unsigned*)(lds + (bufoff) + ldsw + 8192), 16, 0, aux); } while (0)
#define PG8_STAGE_B(bufoff, uoff) PG8_STAGE(bufoff, Bbase + (size_t)(uoff), voffB[0], voffB[1], Sched::AUXB)
#define PG8_STAGE_A(bufoff, uoff, o0, o1) PG8_STAGE(bufoff, Abase + (size_t)(uoff), o0, o1, Sched::AUXA)
#define PG8_AO(U, h, i) unit_ao<GATHER>(U, h, i, voffA)
#define PG8_LDA(dst, b, h) do { _Pragma("unroll") for (int m = 0; m < 4; ++m) _Pragma("unroll") for (int k = 0; k < 2; ++k) dst[m][k] = *(const LAS bf16x8*)(lds + PG8_SA(b, h) + aoff + m * 2048 + k * 1024); } while (0)
#define PG8_LDB(dst, b, h) do { _Pragma("unroll") for (int n = 0; n < 2; ++n) _Pragma("unroll") for (int k = 0; k < 2; ++k) dst[n][k] = *(const LAS bf16x8*)(lds + PG8_SB(b, h) + boff + n * 2048 + k * 1024); } while (0)
#define PG8_MMA(ai, bj, At, Bt) do { __builtin_amdgcn_s_setprio(1); _Pragma("unroll") for (int m = 0; m < 4; ++m) _Pragma("unroll") for (int n = 0; n < 2; ++n) _Pragma("unroll") for (int k = 0; k < 2; ++k) \
        acc[ai][bj][m][n] = __builtin_amdgcn_mfma_f32_16x16x32_bf16(Bt[n][k], At[m][k], acc[ai][bj][m][n], 0, 0, 0); __builtin_amdgcn_s_setprio(0); } while (0)
#define PG8_WAIT_V(n) asm volatile("s_waitcnt vmcnt(" #n ")" ::: "memory")
#define PG8_WAIT_L(n) asm volatile("s_waitcnt lgkmcnt(" #n ")" ::: "memory")
#define PG8_BAR __builtin_amdgcn_s_barrier()
#define PG8_SCHED __builtin_amdgcn_sched_barrier(0)
    Unit<GATHER> cur, nxt; int ui = 0;
    if (!S.next(0, cur, lp)) return;
    f32x4 acc[2][2][4][2];
#pragma unroll
    for (int a = 0; a < 2; ++a)
#pragma unroll
        for (int b = 0; b < 2; ++b)
#pragma unroll
            for (int m = 0; m < 4; ++m)
#pragma unroll
                for (int n = 0; n < 2; ++n) acc[a][b][m][n] = (f32x4){0.f, 0.f, 0.f, 0.f};
    bf16x8 At[4][2], B0[2][2], B1[2][2];
    PG8_STAGE_B(PG8_SB(0, 0), cur.b0); PG8_STAGE_B(PG8_SB(0, 1), cur.b1); PG8_STAGE_A(PG8_SA(0, 0), cur.a0, PG8_AO(cur, 0, 0), PG8_AO(cur, 0, 1)); PG8_STAGE_A(PG8_SA(0, 1), cur.a1, PG8_AO(cur, 1, 0), PG8_AO(cur, 1, 1));
    if (wr == 1) PG8_BAR;
    PG8_WAIT_V(2); PG8_BAR;
    PG8_STAGE_B(PG8_SB(1, 0), cur.b0 + kstepB); PG8_STAGE_A(PG8_SA(1, 0), cur.a0 + kstepA, PG8_AO(cur, 0, 0), PG8_AO(cur, 0, 1)); PG8_STAGE_B(PG8_SB(1, 1), cur.b1 + kstepB);
    PG8_WAIT_V(6); PG8_BAR;
    for (;;) {
        const bool has_next = S.next(ui + 1, nxt, lp);
        if (!has_next) nxt = cur;
        const int nt = cur.nt; const bool full = cur.full != 0;
#define PG8_TRIP(FULL) do { \
              \
            PG8_LDB(B0, 0, 0); PG8_LDB(B1, 0, 1); PG8_SCHED; PG8_LDA(At, 0, 0); PG8_STAGE_A(PG8_SA(1, 1), cur.a1 + k1, PG8_AO(cur, 1, 0), PG8_AO(cur, 1, 1)); \
            PG8_WAIT_V(8); PG8_WAIT_L(0); PG8_BAR; PG8_MMA(0, 0, At, B0); PG8_MMA(0, 1, At, B1); PG8_BAR; PG8_SCHED; \
              \
            PG8_LDA(At, 0, 1); PG8_STAGE_B(PG8_SB(0, 0), b0n); PG8_STAGE_B(PG8_SB(0, 1), b1n); PG8_STAGE_A(PG8_SA(0, 0), a0n, o00, o01); \
            PG8_WAIT_V(8); PG8_WAIT_L(0); PG8_BAR; if (FULL) { PG8_MMA(1, 0, At, B0); PG8_MMA(1, 1, At, B1); } PG8_BAR; PG8_SCHED; \
              \
            PG8_LDB(B0, 1, 0); PG8_LDB(B1, 1, 1); PG8_SCHED; PG8_LDA(At, 1, 0); PG8_STAGE_A(PG8_SA(0, 1), a1n, o10, o11); \
            PG8_WAIT_V(8); PG8_WAIT_L(0); PG8_BAR; PG8_MMA(0, 0, At, B0); PG8_MMA(0, 1, At, B1); PG8_BAR; PG8_SCHED; \
              \
            PG8_LDA(At, 1, 1); PG8_STAGE_B(PG8_SB(1, 0), b0n + kstepB); PG8_STAGE_B(PG8_SB(1, 1), b1n + kstepB); PG8_STAGE_A(PG8_SA(1, 0), a0n + kstepA, o00, o01); \
            PG8_WAIT_V(8); PG8_WAIT_L(0); PG8_BAR; if (FULL) { PG8_MMA(1, 0, At, B0); PG8_MMA(1, 1, At, B1); } PG8_BAR; PG8_SCHED; } while (0)
        if (full) { for (int t = 0; t < nt; t += 2) {
            const bool last = (t == nt - 2);
            const unsigned k1 = (unsigned)(t + 1) * kstepA, k2 = (unsigned)(t + 2) * kstepA, k2b = (unsigned)(t + 2) * kstepB;
            const unsigned a0n = last ? nxt.a0 : cur.a0 + k2, a1n = last ? nxt.a1 : cur.a1 + k2, b0n = last ? nxt.b0 : cur.b0 + k2b, b1n = last ? nxt.b1 : cur.b1 + k2b;
            const unsigned o00 = last ? PG8_AO(nxt, 0, 0) : PG8_AO(cur, 0, 0), o01 = last ? PG8_AO(nxt, 0, 1) : PG8_AO(cur, 0, 1), o10 = last ? PG8_AO(nxt, 1, 0) : PG8_AO(cur, 1, 0), o11 = last ? PG8_AO(nxt, 1, 1) : PG8_AO(cur, 1, 1);
            PG8_TRIP(true); } }
        else { for (int t = 0; t < nt; t += 2) {
            const bool last = (t == nt - 2);
            const unsigned k1 = (unsigned)(t + 1) * kstepA, k2 = (unsigned)(t + 2) * kstepA, k2b = (unsigned)(t + 2) * kstepB;
            const unsigned a0n = last ? nxt.a0 : cur.a0 + k2, a1n = last ? nxt.a1 : cur.a1 + k2, b0n = last ? nxt.b0 : cur.b0 + k2b, b1n = last ? nxt.b1 : cur.b1 + k2b;
            const unsigned o00 = last ? PG8_AO(nxt, 0, 0) : PG8_AO(cur, 0, 0), o01 = last ? PG8_AO(nxt, 0, 1) : PG8_AO(cur, 0, 1), o10 = last ? PG8_AO(nxt, 1, 0) : PG8_AO(cur, 1, 0), o11 = last ? PG8_AO(nxt, 1, 1) : PG8_AO(cur, 1, 1);
            PG8_TRIP(false); } }
#undef PG8_TRIP
        if (wr == 0) PG8_BAR;
        E(acc, cur, wr, wc, fr, fq);
        if (!has_next) break;
#pragma unroll
        for (int a = 0; a < 2; ++a)
#pragma unroll
            for (int b = 0; b < 2; ++b)
#pragma unroll
                for (int m = 0; m < 4; ++m)
#pragma unroll
                    for (int n = 0; n < 2; ++n) acc[a][b][m][n] = (f32x4){0.f, 0.f, 0.f, 0.f};
        cur = nxt; ++ui;
        if (wr == 1) PG8_BAR;
    }
    PG8_WAIT_V(0);
    PG8_BAR;
#undef PG8_SA
#undef PG8_SB
#undef PG8_STAGE
#undef PG8_STAGE_A
#undef PG8_STAGE_B
#undef PG8_AO
#undef PG8_LDA
#undef PG8_LDB
#undef PG8_MMA
#undef PG8_WAIT_V
#undef PG8_WAIT_L
#undef PG8_BAR
#undef PG8_SCHED
}

__device__ __forceinline__ bool static_tile(int i, int G, int c, int nM, int nN, int& pm, int& pn) {
    const int nwg = nM * nN; const long L = (long)i * G + c; if (L >= nwg) return false;
    int wgid = (int)L; { const int q = nwg / 8, r = nwg % 8, xcd = wgid % 8, off = wgid / 8; wgid = (xcd < r ? xcd * (q + 1) : r * (q + 1) + (xcd - r) * q) + off; }
    const int nig = 8 * nN, gid = wgid / nig, fm = gid * 8, gsz = (nM - fm) < 8 ? (nM - fm) : 8;
    pm = fm + ((wgid % nig) % gsz); pn = (wgid % nig) / gsz; return true;
}
struct SchedPlain {
    static constexpr int AUXA = 0, AUXB = 0;
    static constexpr unsigned KSTEPA = 128u;
    static constexpr unsigned KSTEPB = 128u;
    const char* Abase; const char* Bbase; int lda, ldb, nM, nN, K, G, c;
    __device__ __forceinline__ int brow(int r) const { return r; }
    __device__ __forceinline__ bool next(int i, Unit<false>& u, const LanePos& lp) const {
        int pm, pn; if (!static_tile(i, G, c, nM, nN, pm, pn)) return false;
        u.a0 = (unsigned)(pm * 256 * lda) * 2u; u.a1 = u.a0 + (unsigned)(128 * lda) * 2u;
        u.b0 = (unsigned)(pn * 256 * ldb) * 2u; u.b1 = u.b0 + (unsigned)(128 * ldb) * 2u;
        u.nt = K / BK; u.full = 1; u.p0 = pm; u.p1 = pn; u.p2 = 0; return true;
    }
};
}
using pg8::Unit;

#define EPI_LOOP_ROWS for (int ai = 0; ai < 2; ++ai) _Pragma("unroll") for (int m = 0; m < 4; ++m)
struct EpiRaw {
    bf16_t* O; int ldc;
    __device__ __forceinline__ void operator()(const f32x4 (&acc)[2][2][4][2], const Unit<false>& u, int wr, int wc, int fr, int fq) const {
        const int row0 = u.p0 * 256 + wr * 64 + fr, col0 = u.p1 * 256 + wc * 32 + 8 * fq;
#pragma unroll
        EPI_LOOP_ROWS { bf16_t* rowp = O + (size_t)(row0 + ai * 128 + m * 16) * ldc + col0;
#pragma unroll
            for (int bj = 0; bj < 2; ++bj) { const f32x4 v0 = acc[ai][bj][m][0], v1 = acc[ai][bj][m][1];
                u32x4 w; w.x = pk2(v0[0], v0[1]); w.y = pk2(v0[2], v0[3]); w.z = pk2(v1[0], v1[1]); w.w = pk2(v1[2], v1[3]); *(u32x4*)(rowp + bj * 128) = w; } }
    }
};
struct EpiAbIn {
    bf16_t* PA; bf16_t* PZ;
    __device__ __forceinline__ void operator()(const f32x4 (&acc)[2][2][4][2], const Unit<false>& u, int wr, int wc, int fr, int fq) const {
        const int row0 = u.p0 * 256 + wr * 64 + fr; const bool isz = u.p1 >= 4;
        bf16_t* base = isz ? PZ : PA; const int ldc = isz ? 2048 : 1024; const int col0 = (isz ? (u.p1 - 4) : u.p1) * 256 + wc * 32 + 8 * fq;
#pragma unroll
        EPI_LOOP_ROWS { bf16_t* rowp = base + (size_t)(row0 + ai * 128 + m * 16) * ldc + col0;
#pragma unroll
            for (int bj = 0; bj < 2; ++bj) { f32x4 v0 = acc[ai][bj][m][0], v1 = acc[ai][bj][m][1];
                if (isz) {
#pragma unroll
                    for (int j = 0; j < 4; ++j) { v0[j] = gelu_tanh(v0[j]); v1[j] = gelu_tanh(v1[j]); } }
                u32x4 w; w.x = pk2(v0[0], v0[1]); w.y = pk2(v0[2], v0[3]); w.z = pk2(v1[0], v1[1]); w.w = pk2(v1[2], v1[3]); *(u32x4*)(rowp + bj * 128) = w; } }
    }
};
struct EpiChan {
    bf16_t* ZT;
    __device__ __forceinline__ void operator()(const f32x4 (&acc)[2][2][4][2], const Unit<false>& u, int wr, int wc, int fr, int fq) const {
        const int ri = u.p0, tt = u.p1, g = u.p2, b = tt >> 4, tq = tt & 15;
#pragma unroll
        EPI_LOOP_ROWS { const int j = ai * 128 + wr * 64 + m * 16 + fr;
#pragma unroll
            for (int bj = 0; bj < 2; ++bj) { const int col0 = bj * 128 + wc * 32 + 8 * fq, l2 = 4 * tq + (col0 >> 6), l1 = col0 & 63; const f32x4 v0 = acc[ai][bj][m][0], v1 = acc[ai][bj][m][1];
                u32x4 w; w.x = pk2(v0[0], v0[1]); w.y = pk2(v0[2], v0[3]); w.z = pk2(v1[0], v1[1]); w.w = pk2(v1[2], v1[3]);
                *(u32x4*)(ZT + ((((size_t)(b * 1024 + g * 256 + j) * 64 + l2) * 2 + ri) * 64 + l1)) = w; } }
    }
};
struct EpiChanC {
    bf16_t* ZTC;
    __device__ __forceinline__ void operator()(const f32x4 (&acc)[2][2][4][2], const Unit<false>& u, int wr, int wc, int fr, int fq) const {
        const int ri = u.p0, b = u.p1, g = u.p2, l0 = wc * 32 + 8 * fq;
#pragma unroll
        EPI_LOOP_ROWS { const int j = ai * 128 + wr * 64 + m * 16 + fr;
            bf16_t* rowp = ZTC + ((size_t)((b * 1024 + g * 256 + j) * 2 + ri)) * 256 + l0;
#pragma unroll
            for (int bj = 0; bj < 2; ++bj) { const f32x4 v0 = acc[ai][bj][m][0], v1 = acc[ai][bj][m][1];
                u32x4 w; w.x = pk2(v0[0], v0[1]); w.y = pk2(v0[2], v0[3]); w.z = pk2(v1[0], v1[1]); w.w = pk2(v1[2], v1[3]); *(u32x4*)(rowp + bj * 128) = w; } }
    }
};
struct EpiPos {
    bf16_t* MIX;
    __device__ __forceinline__ void operator()(const f32x4 (&acc)[2][2][4][2], const Unit<false>& u, int wr, int wc, int fr, int fq) const {
        const int row0 = u.p0 + wr * 64 + fr, col0 = u.p1 * 256 + wc * 32 + 8 * fq;
#pragma unroll
        EPI_LOOP_ROWS { bf16_t* rowp = MIX + (size_t)(row0 + ai * 128 + m * 16) * D + col0;
#pragma unroll
            for (int bj = 0; bj < 2; ++bj) { const f32x4 v0 = acc[ai][bj][m][0], v1 = acc[ai][bj][m][1];
                u32x4 w; w.x = pk2(v0[0], v0[1]); w.y = pk2(v0[2], v0[3]); w.z = pk2(v1[0], v1[1]); w.w = pk2(v1[2], v1[3]); *(u32x4*)(rowp + bj * 128) = w; } }
    }
};
struct EpiGU {
    bf16_t* ACT; const float* bgu;
    __device__ __forceinline__ void operator()(const f32x4 (&acc)[2][2][4][2], const Unit<true>& u, int wr, int wc, int fr, int fq) const {
        const int row0 = u.p0 + wr * 64 + fr, c0 = u.p1 * 128 + wc * 32 + 8 * fq;
        const float* bg = bgu + (size_t)u.p2 * 2048 + c0; const float* bu = bg + 1024;
        const f32x4 g0 = *(const f32x4*)bg, g1 = *(const f32x4*)(bg + 4), u0 = *(const f32x4*)bu, u1 = *(const f32x4*)(bu + 4);
#pragma unroll
        EPI_LOOP_ROWS { bf16_t* rowp = ACT + ((size_t)(((u.p0 >> 8) * 2 + ai) * 16 + u.p1 * 2 + (wc >> 1)) * 128 + wr * 64 + m * 16 + fr) * 64 + (wc & 1) * 32 + 8 * fq;
            float o[8];
#pragma unroll
            for (int j = 0; j < 4; ++j) {
                { const float gt = fminf(acc[ai][0][m][0][j] + g0[j], 7.0f); const float up = fminf(fmaxf(acc[ai][1][m][0][j] + u0[j], -7.0f), 7.0f); o[j] = gt * sigmoidf_(1.702f * gt) * (up + 1.0f); }
                { const float gt = fminf(acc[ai][0][m][1][j] + g1[j], 7.0f); const float up = fminf(fmaxf(acc[ai][1][m][1][j] + u1[j], -7.0f), 7.0f); o[4 + j] = gt * sigmoidf_(1.702f * gt) * (up + 1.0f); } }
            u32x4 w; w.x = pk2(o[0], o[1]); w.y = pk2(o[2], o[3]); w.z = pk2(o[4], o[5]); w.w = pk2(o[6], o[7]); *(u32x4*)rowp = w; }
    }
};
struct EpiDown {
    bf16_t* YS; const float* bdn;
    __device__ __forceinline__ void operator()(const f32x4 (&acc)[2][2][4][2], const Unit<false>& u, int wr, int wc, int fr, int fq) const {
        const int row0 = u.p0 + wr * 64 + fr, col0 = u.p1 * 256 + wc * 32 + 8 * fq;
        const float* bp = bdn + (size_t)u.p2 * 2048 + col0;
        f32x4 bv[2][2];
#pragma unroll
        for (int bj = 0; bj < 2; ++bj) { bv[bj][0] = *(const f32x4*)(bp + bj * 128); bv[bj][1] = *(const f32x4*)(bp + bj * 128 + 4); }
#pragma unroll
        EPI_LOOP_ROWS { bf16_t* rowp = YS + (size_t)(row0 + ai * 128 + m * 16) * D + col0;
#pragma unroll
            for (int bj = 0; bj < 2; ++bj) { const f32x4 v0 = acc[ai][bj][m][0] + bv[bj][0], v1 = acc[ai][bj][m][1] + bv[bj][1];
                u32x4 w; w.x = pk2(v0[0], v0[1]); w.y = pk2(v0[2], v0[3]); w.z = pk2(v1[0], v1[1]); w.w = pk2(v1[2], v1[3]); *(u32x4*)(rowp + bj * 128) = w; } }
    }
};
struct EpiCdIn {
    bf16_t *Q, *V, *G, *LG, *LX; float* LF; const float* lbraw;
    __device__ __forceinline__ void operator()(const f32x4 (&acc)[2][2][4][2], const Unit<false>& u, int wr, int wc, int fr, int fq) const {
        const int row0 = u.p0 * 256 + wr * 64 + fr, pn = u.p1;
        if (pn >= 4 && pn < 12) {
            const int col0 = (pn - 4) * 256 + wc * 32 + 8 * fq;
            float lb[2][8];
#pragma unroll
            for (int bj = 0; bj < 2; ++bj)
#pragma unroll
                for (int j = 0; j < 8; ++j) { const int kc = (col0 + bj * 128 + j) & 1023; lb[bj][j] = sigmoidf_(lbraw[1024 + kc] - lbraw[kc]); }
#pragma unroll
            EPI_LOOP_ROWS { float* rowp = LF + (size_t)(row0 + ai * 128 + m * 16) * 2048 + col0;
#pragma unroll
                for (int bj = 0; bj < 2; ++bj) { f32x4 o0, o1;
#pragma unroll
                    for (int j = 0; j < 4; ++j) { o0[j] = __logf(lb[bj][j] + (1.0f - lb[bj][j]) * sigmoidf_(acc[ai][bj][m][0][j])); o1[j] = __logf(lb[bj][4 + j] + (1.0f - lb[bj][4 + j]) * sigmoidf_(acc[ai][bj][m][1][j])); }
                    *(f32x4*)(rowp + bj * 128) = o0; *(f32x4*)(rowp + bj * 128 + 4) = o1; } }
            return;
        }
        int act, tl; bf16_t* base;
        if (pn < 4) { base = Q; act = 1; tl = pn; } else if (pn < 16) { base = V; act = 0; tl = pn - 12; } else if (pn < 20) { base = G; act = 1; tl = pn - 16; }
        else if (pn < 24) { base = LG; act = 2; tl = pn - 20; } else { base = LX; act = 0; tl = pn - 24; }
        const int col0 = tl * 256 + wc * 32 + 8 * fq;
#pragma unroll
        EPI_LOOP_ROWS { bf16_t* rowp = base + (size_t)(row0 + ai * 128 + m * 16) * 1024 + col0;
#pragma unroll
            for (int bj = 0; bj < 2; ++bj) { f32x4 v0 = acc[ai][bj][m][0], v1 = acc[ai][bj][m][1];
                if (act == 1) {
#pragma unroll
                    for (int j = 0; j < 4; ++j) { v0[j] = siluf_(v0[j]); v1[j] = siluf_(v1[j]); } }
                if (act == 2) {
#pragma unroll
                    for (int j = 0; j < 4; ++j) { v0[j] = gelu_tanh(v0[j]); v1[j] = gelu_tanh(v1[j]); } }
                u32x4 w; w.x = pk2(v0[0], v0[1]); w.y = pk2(v0[2], v0[3]); w.z = pk2(v1[0], v1[1]); w.w = pk2(v1[2], v1[3]); *(u32x4*)(rowp + bj * 128) = w; } }
    }
};

struct SchedChan {
    static constexpr int AUXA = 0, AUXB = 0;
    static constexpr unsigned KSTEPA = 128u;
    static constexpr unsigned KSTEPB = 128u;
    const char* Abase; const char* Bbase; int lda, ldb, G, c;
    __device__ __forceinline__ int brow(int r) const { return 64 * (r & 63) + (r >> 6); }
    __device__ __forceinline__ bool next(int i, Unit<false>& u, const pg8::LanePos& lp) const {
        const int L = i * G + c; if (L >= 4 * 2 * 32) return false;
        const int tt = L & 31, ri = (L >> 5) & 1, g = L >> 6, b = tt >> 4, tq = tt & 15;
        u.a0 = (unsigned)(ri * 256 * 256) * 2u; u.a1 = u.a0 + (unsigned)(128 * 256) * 2u;
        u.b0 = (unsigned)((b * 4096 + 4 * tq) * 1024 + g * 256) * 2u; u.b1 = u.b0 + (unsigned)(2 * 1024) * 2u;
        u.nt = 4; u.full = 1; u.p0 = ri; u.p1 = tt; u.p2 = g; return true;
    }
};
struct SchedChanC {
    static constexpr int AUXA = 0, AUXB = 0;
    static constexpr unsigned KSTEPA = 128u;
    static constexpr unsigned KSTEPB = 128u;
    const char* Abase; const char* Bbase; int lda, ldb, G, c;
    __device__ __forceinline__ int brow(int r) const { return r; }
    __device__ __forceinline__ bool next(int i, Unit<false>& u, const pg8::LanePos& lp) const {
        const int L = i * G + c; if (L >= 4 * 2 * 2) return false;
        const int b = L & 1, ri = (L >> 1) & 1, g = L >> 2;
        u.a0 = (unsigned)(ri * 256 * 256) * 2u; u.a1 = u.a0 + (unsigned)(128 * 256) * 2u;
        u.b0 = (unsigned)((NLAT + b * 256) * 1024 + g * 256) * 2u; u.b1 = u.b0 + (unsigned)(128 * 1024) * 2u;
        u.nt = 4; u.full = 1; u.p0 = ri; u.p1 = b; u.p2 = g; return true;
    }
};
struct SchedPosC {
    static constexpr int AUXA = 0, AUXB = 0;
    static constexpr unsigned KSTEPA = 128u;
    static constexpr unsigned KSTEPB = 128u;
    const char* Abase; const char* Bbase; int lda, ldb, G, c;
    __device__ __forceinline__ int brow(int r) const { return r; }
    __device__ __forceinline__ bool next(int i, Unit<false>& u, const pg8::LanePos& lp) const {
        const int L = i * G + c; if (L >= 8) return false;
        const int b = L >> 2, pn = L & 3;
        u.a0 = 0u; u.a1 = 128u * 512u * 2u;
        u.b0 = (unsigned)(b * 1024 + pn * 256) * 512u * 2u; u.b1 = u.b0 + 128u * 512u * 2u;
        u.nt = 8; u.full = 1; u.p0 = NLAT + b * 256; u.p1 = pn; u.p2 = 0; return true;
    }
};
struct SchedGU {
#ifndef MOE_AUXA
#define MOE_AUXA 0
#endif
#ifndef MOE_AUXB
#define MOE_AUXB 2
#endif
    static constexpr int AUXA = MOE_AUXA, AUXB = MOE_AUXB;
    static constexpr unsigned KSTEPA = 128u;
    static constexpr unsigned KSTEPB = 16384u;
    const char* Abase; const char* Bbase; const int* list; const LAS int* tpre; const LAS int* tcnt; int lda, ldb, G, c;
    __device__ __forceinline__ int brow(int r) const { return r; }
    __device__ __forceinline__ bool next(int i, Unit<true>& u, const pg8::LanePos& lp) const {
        const int ntile = tpre[32]; int ti, pn;
        if ((G & 255) == 0) { const int x = c & 7, y = (c >> 3) & 31, blk = c >> 8; ti = 32 * (i * (G >> 8) + blk) + 8 * (x >> 1) + (y >> 2); pn = 4 * (x & 1) + (y & 3); }
        else { const int L = i * G + c; ti = L >> 3; pn = L & 7; }
        if (ti >= ntile) return false;
        int e = 0;
        for (int q = 1; q < 32; ++q) e += (tpre[q] <= ti) ? 1 : 0;
        const int mt = ti - tpre[e], cnt = tcnt[e];
        u.a0 = 0u; u.a1 = 0u;
#pragma unroll
        for (int h = 0; h < 2; ++h)
#pragma unroll
            for (int p = 0; p < 2; ++p) { int rk = mt * 256 + h * 128 + lp.R[p]; rk = rk < cnt ? rk : cnt - 1; const int tok = list[e * LCAP + rk]; u.ao[h][p] = (unsigned)(tok * D + lp.C[p]) * 2u; }
        u.b0 = (unsigned)(e * 2048 * D + pn * (D / 64) * 8192) * 2u; u.b1 = u.b0 + (unsigned)(8 * (D / 64) * 8192) * 2u;
        u.nt = D / 64; u.full = (cnt - mt * 256 > 128) ? 1 : 0; u.p0 = ti * 256; u.p1 = pn; u.p2 = e; return true;
    }
};
struct SchedDown {
#ifndef MOE_AUXA
#define MOE_AUXA 0
#endif
#ifndef MOE_AUXB
#define MOE_AUXB 2
#endif
    static constexpr int AUXA = MOE_AUXA, AUXB = MOE_AUXB;
    static constexpr unsigned KSTEPA = 16384u;
    static constexpr unsigned KSTEPB = 16384u;
    const char* Abase; const char* Bbase; const LAS int* tpre; const LAS int* tcnt; int lda, ldb, G, c;
    __device__ __forceinline__ int brow(int r) const { return r; }
    __device__ __forceinline__ bool next(int i, Unit<false>& u, const pg8::LanePos& lp) const {
        const int ntile = tpre[32]; int ti, pn;
        if ((G & 255) == 0) { const int x = c & 7, y = (c >> 3) & 31, blk = c >> 8; ti = 32 * (i * (G >> 8) + blk) + 8 * (x >> 1) + (y >> 2); pn = 4 * (x & 1) + (y & 3); }
        else { const int L = i * G + c; ti = L >> 3; pn = L & 7; }
        if (ti >= ntile) return false;
        int e = 0;
        for (int q = 1; q < 32; ++q) e += (tpre[q] <= ti) ? 1 : 0;
        u.a0 = (unsigned)(ti * 256 * DE) * 2u; u.a1 = u.a0 + (unsigned)(128 * DE) * 2u;
        u.b0 = (unsigned)(e * 2048 * DE + 2 * pn * (DE / 64) * 8192) * 2u; u.b1 = u.b0 + (unsigned)((DE / 64) * 8192) * 2u;
        u.nt = DE / 64; u.full = (tcnt[e] - (ti - tpre[e]) * 256 > 128) ? 1 : 0; u.p0 = ti * 256; u.p1 = pn; u.p2 = e; return true;
    }
};

struct Args { const float* in[29]; float* out; unsigned char* ws; int ph_lo, ph_hi; };
typedef const __attribute__((address_space(4))) Args* KA;
__device__ __forceinline__ KA get_args() { KA p = (KA)__builtin_amdgcn_kernarg_segment_ptr(); asm volatile("" : "+s"(p)); return p; }
enum { I_X = 0, I_C, I_CTX, I_CCTX, I_MODW, I_MODB, I_NORMG, I_ABIN, I_ABOUT, I_VG, I_WS, I_BS, I_CDIN, I_CDOUT, I_LB, I_ONORM, I_CONVW, I_CONVB, I_WR, I_BR, I_WI, I_BI, I_LAM,
       I_RW, I_RB, I_WGU, I_BGU, I_WDN, I_BDN };

struct TrItem { const float* src; bf16_t* dst; int dj, N, db; };
template <bool GROUP8 = true, bool TILED = false>
__device__ __forceinline__ void tr_set(TrItem& t, const float* W, int K, int N, bf16_t* WT, int item, int lane) {
    const int nblk = N >> 5, nb = GROUP8 ? ((item >> 3) % (nblk >> 3)) * 8 + (item & 7) : item % nblk, kb = GROUP8 ? (item >> 3) / (nblk >> 3) : item / nblk, k0 = kb * 128, n0 = nb * 32, nq = lane & 7, ko = lane >> 3;
    t.src = W + (size_t)(k0 + 8 * ko) * N + n0 + 4 * nq; t.N = N;
    if (TILED) { t.dst = WT + ((size_t)((n0 >> 7) * (K >> 6) + 2 * kb) * 128 + (n0 & 127) + 4 * nq) * 64 + 8 * ko; t.dj = 64; t.db = 8192; }
    else { t.dst = WT + (size_t)(n0 + 4 * nq) * K + k0 + 8 * ko; t.dj = K; t.db = 64; }
}
__device__ __forceinline__ void tr_load(const TrItem& t, f32x4 (&v)[16]) {
#pragma unroll
    for (int i = 0; i < 16; ++i) v[i] = __builtin_nontemporal_load((const f32x4*)(t.src + (size_t)((i & 7) + 64 * (i >> 3)) * t.N));
}
__device__ __forceinline__ void tr_store(const TrItem& t, const f32x4 (&v)[16]) {
#pragma unroll
    for (int j = 0; j < 4; ++j) {
        u32x4 a, b;
        a.x = pk2(v[0][j], v[1][j]); a.y = pk2(v[2][j], v[3][j]); a.z = pk2(v[4][j], v[5][j]); a.w = pk2(v[6][j], v[7][j]);
        b.x = pk2(v[8][j], v[9][j]); b.y = pk2(v[10][j], v[11][j]); b.z = pk2(v[12][j], v[13][j]); b.w = pk2(v[14][j], v[15][j]);
        *(u32x4*)(t.dst + (size_t)j * t.dj) = a; *(u32x4*)(t.dst + (size_t)j * t.dj + t.db) = b;
    }
}
__device__ __forceinline__ void transpose_item(const float* __restrict__ W, int K, int N, bf16_t* __restrict__ WT, int item, int lane) {
    TrItem t; tr_set<false>(t, W, K, N, WT, item, lane); f32x4 v[16]; tr_load(t, v); tr_store(t, v);
}
constexpr int TR_A = (D / 64) * (AB_COLS / 64), TR_O = (D / 64) * (D / 64), TR_CD = (D / 64) * (CD_COLS / 64), TR_GU1 = (D / 64) * (2048 / 64), TR_DN1 = (DE / 64) * (D / 64);
constexpr int TR_NIT = TR_A + 2 * TR_O + TR_CD + 64 * TR_GU1 + 64 * TR_DN1;
__device__ __forceinline__ void tr_decode(KA a, unsigned char* ws, int it, int lane, TrItem& t) {
    int r = it;
    if (r < TR_A) { tr_set(t, a->in[I_ABIN], D, AB_COLS, (bf16_t*)(ws + WS_WABIN), r, lane); return; } r -= TR_A;
    if (r < TR_O) { tr_set(t, a->in[I_ABOUT], D, D, (bf16_t*)(ws + WS_WOUT), r, lane); return; } r -= TR_O;
    if (r < TR_O) { tr_set(t, a->in[I_CDOUT], D, D, (bf16_t*)(ws + WS_WOUT) + (size_t)D * D, r, lane); return; } r -= TR_O;
    if (r < TR_CD) { tr_set(t, a->in[I_CDIN], D, CD_COLS, (bf16_t*)(ws + WS_WCDIN), r, lane); return; } r -= TR_CD;
    { const int layer = r >= 32 * (TR_GU1 + TR_DN1) ? 1 : 0; r -= layer * 32 * (TR_GU1 + TR_DN1);
      if (r < 32 * TR_GU1) { const int m = layer * 32 + r / TR_GU1; tr_set<true, true>(t, a->in[I_WGU] + (size_t)m * D * 2048, D, 2048, (bf16_t*)(ws + WS_WGU) + (size_t)m * 2048 * D, r % TR_GU1, lane); return; } r -= 32 * TR_GU1;
      { const int m = layer * 32 + r / TR_DN1; tr_set<true, true>(t, a->in[I_WDN] + (size_t)m * DE * D, DE, D, (bf16_t*)(ws + WS_WDN) + (size_t)m * D * DE, r % TR_DN1, lane); } }
}
constexpr int FILL6_PERW = 6, FILL6_B0 = 16;
constexpr int FILL3_PERW = 6, FILL3_B0 = 152;
constexpr int FILL11_PERW = 6, FILL11_B0 = 184;
constexpr int TR_F6 = (256 - FILL6_B0) * 8 * FILL6_PERW, TR_F3 = (256 - FILL3_B0) * 8 * FILL3_PERW, TR_F11 = (256 - FILL11_B0) * 8 * FILL11_PERW, TR_FILL = TR_F6 + TR_F3 + TR_F11;
__device__ __forceinline__ void tr_run(KA a, unsigned char* ws, int it0, int it_end, int stride, int lane) {
    int it = it0;
    if (it < it_end) {
        TrItem tA, tB; f32x4 va[16], vb[16];
        tr_decode(a, ws, it, lane, tA); tr_load(tA, va);
        for (;;) {
            int nx = it + stride; bool hn = nx < it_end;
            if (hn) { tr_decode(a, ws, nx, lane, tB); tr_load(tB, vb); }
            tr_store(tA, va); if (!hn) break; it = nx;
            nx = it + stride; hn = nx < it_end;
            if (hn) { tr_decode(a, ws, nx, lane, tA); tr_load(tA, va); }
            tr_store(tB, vb); if (!hn) break; it = nx;
        }
    }
}
__device__ __forceinline__ void phase_prologue(KA a, int gw, int ngw, int lane) {
    unsigned char* ws = a->ws;
    for (int t = gw; t < 2 * 48 * KSPLIT; t += ngw) {
        const int kc = t % KSPLIT, slab = (t / KSPLIT) % 48, layer = t / (KSPLIT * 48);
        const int n0 = slab * 256 + lane * 4, k0 = kc * (D / KSPLIT);
        const float* w = a->in[I_MODW] + ((size_t)layer * D + k0) * (6 * D) + n0;
        const float cA0 = siluf_(a->in[I_C][k0 + lane]), cA1 = siluf_(a->in[I_C][D + k0 + lane]), cA2 = siluf_(a->in[I_CCTX][k0 + lane]);
        const float cB0 = siluf_(a->in[I_C][k0 + 64 + lane]), cB1 = siluf_(a->in[I_C][D + k0 + 64 + lane]), cB2 = siluf_(a->in[I_CCTX][k0 + 64 + lane]);
        f32x4 acc0 = {0.f, 0.f, 0.f, 0.f}, acc1 = acc0, acc2 = acc0;
#pragma unroll 16
        for (int k = 0; k < 64; ++k) {
            const f32x4 wv = __builtin_nontemporal_load((const f32x4*)(w + (size_t)k * (6 * D)));
            const float c0 = rdl(cA0, k), c1 = rdl(cA1, k), c2 = rdl(cA2, k);
            acc0 += wv * c0; acc1 += wv * c1; acc2 += wv * c2;
        }
#pragma unroll 16
        for (int k = 0; k < 64; ++k) {
            const f32x4 wv = __builtin_nontemporal_load((const f32x4*)(w + (size_t)(64 + k) * (6 * D)));
            const float c0 = rdl(cB0, k), c1 = rdl(cB1, k), c2 = rdl(cB2, k);
            acc0 += wv * c0; acc1 += wv * c1; acc2 += wv * c2;
        }
        float* mp = (float*)(ws + WS_MODP) + ((size_t)(kc * 2 + layer) * 3) * (6 * D) + n0;
        *(f32x4*)mp = acc0; *(f32x4*)(mp + 6 * D) = acc1; *(f32x4*)(mp + 12 * D) = acc2;
    }
    if (ngw == 2048) tr_run(a, ws, gw, TR_NIT - TR_FILL, ngw, lane); else tr_run(a, ws, gw, TR_NIT, ngw, lane);
    for (int it = gw; it < 2 * 32 * 4; it += ngw) { const int layer = it >> 7, e = (it >> 2) & 31, d0 = (it & 3) * 512 + lane * 8; const float* rwp = a->in[I_RW] + ((size_t)layer * D + d0) * NE + e;
        float hi[8], lo[8];
#pragma unroll
        for (int j = 0; j < 8; ++j) { const float w = rwp[(size_t)j * NE]; hi[j] = bflo(pk2(w, 0.f)); lo[j] = w - hi[j]; }
        u32x4 wh, wl; wh.x = pk2(hi[0], hi[1]); wh.y = pk2(hi[2], hi[3]); wh.z = pk2(hi[4], hi[5]); wh.w = pk2(hi[6], hi[7]); wl.x = pk2(lo[0], lo[1]); wl.y = pk2(lo[2], lo[3]); wl.z = pk2(lo[4], lo[5]); wl.w = pk2(lo[6], lo[7]);
        *(u32x4*)((bf16_t*)(ws + WS_RWH) + ((size_t)layer * 32 + e) * D + d0) = wh; *(u32x4*)((bf16_t*)(ws + WS_RWL) + ((size_t)layer * 32 + e) * D + d0) = wl; }
    for (int it = gw; it < 2 * 2 * 8 * 4; it += ngw) { const int m = it >> 2, dir = m >> 4, mat = (m >> 3) & 1, hh = m & 7;
        transpose_item(a->in[mat == 0 ? I_WR : I_WI] + (size_t)(dir * 8 + hh) * 128 * 128, 128, 128, (bf16_t*)(ws + WS_WRT) + (size_t)((dir * 2 + mat) * 8 + hh) * 128 * 128, it & 3, lane); }
    for (int it = gw; it < 128 + 64; it += ngw) {
        const int c0 = lane * 2; float v[2];
        if (it < 128) { const int rip = it >> 6, k1 = it & 63;
#pragma unroll
            for (int j = 0; j < 2; ++j) { const int col = c0 + j, ri = col >> 6, l1 = col & 63; const float fr = (float)((k1 * l1) & 63) * (1.0f / 64.0f);
                v[j] = rip == ri ? __builtin_amdgcn_cosf(fr) : (rip == 0 ? __builtin_amdgcn_sinf(fr) : -__builtin_amdgcn_sinf(fr)); }
            *(unsigned*)((bf16_t*)(ws + WS_FA) + it * 128 + c0) = pk2(v[0], v[1]);
        } else { const int k2 = it - 128;
#pragma unroll
            for (int j = 0; j < 2; ++j) { const int col = c0 + j, ri = col >> 6, l2 = col & 63; const float fr = (float)((k2 * l2) & 63) * (1.0f / 64.0f);
                v[j] = (ri == 0 ? __builtin_amdgcn_cosf(fr) : __builtin_amdgcn_sinf(fr)) * (1.0f / 1024.0f); }
            *(unsigned*)((bf16_t*)(ws + WS_GC) + k2 * 128 + c0) = pk2(v[0], v[1]);
        }
    }
    for (int it = gw; it < 256 + 256; it += ngw) {
        const int c0 = lane * 8; float v[8];
        if (it < 256) { const int k = it;
#pragma unroll
            for (int j = 0; j < 8; ++j) { const int col = c0 + j, l = col & 255; const float fr = (float)((k * l) & 255) * (1.0f / 256.0f);
                v[j] = (col < 256 ? __builtin_amdgcn_cosf(fr) : __builtin_amdgcn_sinf(fr)) * (1.0f / 256.0f); }
            u32x4 w; w.x = pk2(v[0], v[1]); w.y = pk2(v[2], v[3]); w.z = pk2(v[4], v[5]); w.w = pk2(v[6], v[7]);
            *(u32x4*)((bf16_t*)(ws + WS_DLC) + (size_t)k * 512 + c0) = w;
        } else { const int r2 = (it - 256) * 2;
            const int row = r2 + (lane >> 5), cc = (lane & 31) * 8, jj = row & 255;
#pragma unroll
            for (int j = 0; j < 8; ++j) { const float fr = (float)((jj * (cc + j)) & 255) * (1.0f / 256.0f); v[j] = row < 256 ? __builtin_amdgcn_cosf(fr) : -__builtin_amdgcn_sinf(fr); }
            u32x4 w; w.x = pk2(v[0], v[1]); w.y = pk2(v[2], v[3]); w.z = pk2(v[4], v[5]); w.w = pk2(v[6], v[7]);
            *(u32x4*)((bf16_t*)(ws + WS_F256) + (size_t)row * 256 + cc) = w;
        }
    }
}
__device__ __forceinline__ void phase_modfinal(KA a, int gt, int ngt) {
    const float* mp = (const float*)(a->ws + WS_MODP); float* mv = (float*)(a->ws + WS_MODV);
    for (int i = gt; i < 2 * 3 * 6 * D; i += ngt) {
        const int n = i % (6 * D), layer = i / (3 * 6 * D);
        float s = a->in[I_MODB][layer * 6 * D + n];
#pragma unroll
        for (int kc = 0; kc < KSPLIT; ++kc) s += mp[(size_t)kc * (2 * 3 * 6 * D) + i];
        mv[i] = s;
    }
}

struct Row32 { float v[32]; };
__device__ __forceinline__ void load_row_f32(const float* p, int lane, Row32& r) {
#pragma unroll
    for (int j = 0; j < 4; ++j) { const f32x4 a = *(const f32x4*)(p + 8 * lane + 512 * j), b = *(const f32x4*)(p + 8 * lane + 512 * j + 4);
        r.v[8 * j + 0] = a[0]; r.v[8 * j + 1] = a[1]; r.v[8 * j + 2] = a[2]; r.v[8 * j + 3] = a[3]; r.v[8 * j + 4] = b[0]; r.v[8 * j + 5] = b[1]; r.v[8 * j + 6] = b[2]; r.v[8 * j + 7] = b[3]; }
}
__device__ __forceinline__ void store_row_f32(float* p, int lane, const Row32& r) {
#pragma unroll
    for (int j = 0; j < 4; ++j) { *(f32x4*)(p + 8 * lane + 512 * j) = (f32x4){r.v[8 * j], r.v[8 * j + 1], r.v[8 * j + 2], r.v[8 * j + 3]}; *(f32x4*)(p + 8 * lane + 512 * j + 4) = (f32x4){r.v[8 * j + 4], r.v[8 * j + 5], r.v[8 * j + 6], r.v[8 * j + 7]}; }
}
__device__ __forceinline__ void load_row_bf16(const bf16_t* p, int lane, Row32& r) {
#pragma unroll
    for (int j = 0; j < 4; ++j) { const u32x4 w = *(const u32x4*)(p + 8 * lane + 512 * j);
        r.v[8 * j + 0] = bflo(w.x); r.v[8 * j + 1] = bfhi(w.x); r.v[8 * j + 2] = bflo(w.y); r.v[8 * j + 3] = bfhi(w.y); r.v[8 * j + 4] = bflo(w.z); r.v[8 * j + 5] = bfhi(w.z); r.v[8 * j + 6] = bflo(w.w); r.v[8 * j + 7] = bfhi(w.w); }
}
__device__ __forceinline__ void store_row_bf16(bf16_t* p, int lane, const Row32& r) {
#pragma unroll
    for (int j = 0; j < 4; ++j) { u32x4 w; w.x = pk2(r.v[8 * j], r.v[8 * j + 1]); w.y = pk2(r.v[8 * j + 2], r.v[8 * j + 3]); w.z = pk2(r.v[8 * j + 4], r.v[8 * j + 5]); w.w = pk2(r.v[8 * j + 6], r.v[8 * j + 7]); *(u32x4*)(p + 8 * lane + 512 * j) = w; }
}
__device__ __forceinline__ float row_rstd(const Row32& r) { float s = 0.f;
#pragma unroll
    for (int i = 0; i < 32; ++i) s += r.v[i] * r.v[i];
    return rsqrtf(wave_sum(s) * (1.0f / D) + EPS); }
__device__ __forceinline__ void norm_mod(const Row32& x, const float* g, const float* sc, const float* sh, int lane, Row32& hx) {
    const float rs = row_rstd(x); Row32 gg, s1, s0; load_row_f32(g, lane, gg); load_row_f32(sc, lane, s1); load_row_f32(sh, lane, s0);
#pragma unroll
    for (int i = 0; i < 32; ++i) hx.v[i] = x.v[i] * rs * gg.v[i] * (1.0f + s1.v[i]) + s0.v[i];
}
__device__ __forceinline__ void lds_fill(LAS float* dst, const float* src, int n, int tid) { for (int i = tid * 4; i < n; i += NTHR * 4) *(LAS f32x4*)(dst + i) = *(const f32x4*)(src + i); }
__device__ __forceinline__ void load_row_lds(const LAS float* p, int lane, Row32& r) {
#pragma unroll
    for (int j = 0; j < 4; ++j) { const f32x4 a = *(const LAS f32x4*)(p + 8 * lane + 512 * j), b = *(const LAS f32x4*)(p + 8 * lane + 512 * j + 4);
        r.v[8 * j + 0] = a[0]; r.v[8 * j + 1] = a[1]; r.v[8 * j + 2] = a[2]; r.v[8 * j + 3] = a[3]; r.v[8 * j + 4] = b[0]; r.v[8 * j + 5] = b[1]; r.v[8 * j + 6] = b[2]; r.v[8 * j + 7] = b[3]; }
}
__device__ __forceinline__ void norm_mod_l(const Row32& x, const LAS float* g, const LAS float* sc, const LAS float* sh, int lane, Row32& hx) {
    const float rs = row_rstd(x); Row32 gg, s1, s0; load_row_lds(g, lane, gg); load_row_lds(sc, lane, s1); load_row_lds(sh, lane, s0);
#pragma unroll
    for (int i = 0; i < 32; ++i) hx.v[i] = x.v[i] * rs * gg.v[i] * (1.0f + s1.v[i]) + s0.v[i];
}
__device__ __forceinline__ int mod_row(int r) { return r < NLAT ? (r >> 12) : 2; }
__device__ __forceinline__ const float* in_row(KA a, int r) { return r < NLAT ? a->in[I_X] + (size_t)r * D : a->in[I_CTX] + (size_t)(r - NLAT) * D; }

__device__ __forceinline__ void phase_h0(KA a, int gw, int ngw, int lane, int tid, LAS unsigned char* lds) {
    const float* mv = (const float*)(a->ws + WS_MODV); bf16_t* H = (bf16_t*)(a->ws + WS_H);
    LAS float* Lg = (LAS float*)lds; LAS float* Lm = Lg + D;
    __syncthreads();
    lds_fill(Lg, a->in[I_NORMG], D, tid);
    for (int mr = 0; mr < 3; ++mr) lds_fill(Lm + mr * 2 * D, mv + (size_t)mr * 6 * D, 2 * D, tid);
    __syncthreads();
    for (int r = gw; r < NTOK; r += ngw) {
        Row32 x, h; load_row_f32(in_row(a, r), lane, x);
        const LAS float* m = Lm + mod_row(r) * 2 * D;
        norm_mod_l(x, Lg, m + D, m, lane, h);
        store_row_bf16(H + (size_t)r * D, lane, h);
    }
    __syncthreads();
}

constexpr int RA_LD = 2056;
__device__ __forceinline__ void phase_row1(KA a, int layer, int nrows, int bid, int G, int wave, int lane, LAS unsigned char* lds) {
    unsigned char* ws = a->ws;
    const int gw = bid * NWAVES + wave, ngw = G * NWAVES, fr = lane & 15, fq = lane >> 4;
    const float* mv = (const float*)(ws + WS_MODV) + (size_t)layer * 3 * 6 * D; const float* ng = a->in[I_NORMG] + (size_t)layer * 4 * D;
    const bf16_t* O = (const bf16_t*)(ws + WS_O + LOFF(layer)); float* XL = (float*)(ws + WS_XL); bf16_t* H = (bf16_t*)(ws + WS_H2 + LOFF(layer));
    const bf16_t* WH = (const bf16_t*)(ws + WS_RWH) + (size_t)layer * 32 * D; const bf16_t* WL = (const bf16_t*)(ws + WS_RWL) + (size_t)layer * 32 * D; const float* rb = a->in[I_RB] + layer * NE;
    unsigned* cnt = (unsigned*)(ws + WS_CTL) + CW_CNT + 32 * layer * CNT_STRIDE;
    int* toke = (int*)(ws + WS_TOKE + LOFF(layer)); int* tokr = (int*)(ws + WS_TOKR + LOFF(layer)); float* tokp = (float*)(ws + WS_TOKP + LOFF(layer)); int* list = (int*)(ws + WS_LIST + LOFF(layer));
    LAS bf16_t* AH = (LAS bf16_t*)lds; LAS bf16_t* AL = (LAS bf16_t*)(lds + 16 * RA_LD * 2);
    LAS float* part = (LAS float*)lds;
    LAS float* fl = (LAS float*)(lds + 16384);
    LAS int* sel_e = (LAS int*)(lds + 131584); LAS float* sel_p = (LAS float*)(lds + 132224);
    LAS int* sel_l = (LAS int*)(lds + 132864);
    LAS int* hist = (LAS int*)(lds + 133504); LAS int* base = hist + 32;
    __syncthreads();
    if ((int)threadIdx.x < 160) sel_e[threadIdx.x] = -1;
    if ((int)threadIdx.x < 32) hist[threadIdx.x] = 0;
    for (int k0 = 0; bid * NWAVES + k0 * ngw < nrows; k0 += 2) {
        __syncthreads();
#pragma unroll
        for (int q = 0; q < 2; ++q) {
            const int r = gw + (k0 + q) * ngw; LAS bf16_t* ah = AH + (2 * wave + q) * RA_LD; LAS bf16_t* al = AL + (2 * wave + q) * RA_LD;
            if (r < nrows) {
                const float* m = mv + (size_t)mod_row(r) * 6 * D;
                Row32 o, x; load_row_bf16(O + (size_t)r * D, lane, o);
                if (layer == 0) load_row_f32(in_row(a, r), lane, x); else load_row_f32(XL + (size_t)r * D, lane, x);
                { const float rs = row_rstd(o); Row32 g1, ga; load_row_f32(ng + D, lane, g1); load_row_f32(m + 2 * D, lane, ga);
#pragma unroll
                  for (int i = 0; i < 32; ++i) x.v[i] += ga.v[i] * (o.v[i] * rs * g1.v[i]); }
                store_row_f32(XL + (size_t)r * D, lane, x);
                Row32 h; norm_mod(x, ng + 2 * D, m + 4 * D, m + 3 * D, lane, h);
#pragma unroll
                for (int j = 0; j < 4; ++j) { u32x4 wh, wl; float lo[8];
                    wh.x = pk2(h.v[8 * j], h.v[8 * j + 1]); wh.y = pk2(h.v[8 * j + 2], h.v[8 * j + 3]); wh.z = pk2(h.v[8 * j + 4], h.v[8 * j + 5]); wh.w = pk2(h.v[8 * j + 6], h.v[8 * j + 7]);
                    lo[0] = h.v[8 * j] - bflo(wh.x); lo[1] = h.v[8 * j + 1] - bfhi(wh.x); lo[2] = h.v[8 * j + 2] - bflo(wh.y); lo[3] = h.v[8 * j + 3] - bfhi(wh.y);
                    lo[4] = h.v[8 * j + 4] - bflo(wh.z); lo[5] = h.v[8 * j + 5] - bfhi(wh.z); lo[6] = h.v[8 * j + 6] - bflo(wh.w); lo[7] = h.v[8 * j + 7] - bfhi(wh.w);
                    wl.x = pk2(lo[0], lo[1]); wl.y = pk2(lo[2], lo[3]); wl.z = pk2(lo[4], lo[5]); wl.w = pk2(lo[6], lo[7]);
                    *(u32x4*)(H + (size_t)r * D + 8 * lane + 512 * j) = wh;
                    *(LAS u32x4*)(ah + 8 * lane + 512 * j) = wh; *(LAS u32x4*)(al + 8 * lane + 512 * j) = wl; }
            } else {
#pragma unroll
                for (int j = 0; j < 4; ++j) { *(LAS u32x4*)(ah + 8 * lane + 512 * j) = (u32x4){0u, 0u, 0u, 0u}; *(LAS u32x4*)(al + 8 * lane + 512 * j) = (u32x4){0u, 0u, 0u, 0u}; }
            }
        }
        __syncthreads();
        f32x4 acc[2] = {(f32x4){0.f, 0.f, 0.f, 0.f}, (f32x4){0.f, 0.f, 0.f, 0.f}};
#pragma unroll
        for (int hf = 0; hf < 2; ++hf) {
            bf16x8 bh[2][4], bl[2][4];
#pragma unroll
            for (int nt = 0; nt < 2; ++nt)
#pragma unroll
                for (int ks = 0; ks < 4; ++ks) { const size_t off = (size_t)(16 * nt + fr) * D + 256 * wave + 128 * hf + 32 * ks + 8 * fq; bh[nt][ks] = *(const bf16x8*)(WH + off); bl[nt][ks] = *(const bf16x8*)(WL + off); }
#pragma unroll
            for (int ks = 0; ks < 4; ++ks) { const int kk = 256 * wave + 128 * hf + 32 * ks + 8 * fq; const bf16x8 ah8 = *(const LAS bf16x8*)(AH + fr * RA_LD + kk), al8 = *(const LAS bf16x8*)(AL + fr * RA_LD + kk);
#pragma unroll
                for (int nt = 0; nt < 2; ++nt) { acc[nt] = __builtin_amdgcn_mfma_f32_16x16x32_bf16(ah8, bh[nt][ks], acc[nt], 0, 0, 0); acc[nt] = __builtin_amdgcn_mfma_f32_16x16x32_bf16(al8, bh[nt][ks], acc[nt], 0, 0, 0);
                    acc[nt] = __builtin_amdgcn_mfma_f32_16x16x32_bf16(ah8, bl[nt][ks], acc[nt], 0, 0, 0); } }
        }
        __syncthreads();
#pragma unroll
        for (int nt = 0; nt < 2; ++nt)
#pragma unroll
            for (int r4 = 0; r4 < 4; ++r4) part[(wave * 16 + 4 * fq + r4) * 32 + 16 * nt + fr] = acc[nt][r4];
        __syncthreads();
        { const int q = lane >> 5, e = lane & 31, row = 2 * wave + q; float s = rb[e];
#pragma unroll
          for (int w8 = 0; w8 < 8; ++w8) s += part[(w8 * 16 + row) * 32 + e];
          fl[row * 32 + e] = s; }
        asm volatile("s_waitcnt lgkmcnt(0)" ::: "memory");
        { const int q = lane >> 5, r = gw + (k0 + q) * ngw; float lg[NE];
#pragma unroll
          for (int e4 = 0; e4 < 8; ++e4) { const f32x4 v = *(const LAS f32x4*)(fl + (2 * wave + q) * 32 + 4 * e4); lg[4 * e4] = v[0]; lg[4 * e4 + 1] = v[1]; lg[4 * e4 + 2] = v[2]; lg[4 * e4 + 3] = v[3]; }
          unsigned taken = 0u; float tv[4]; int te[4];
#pragma unroll
          for (int k = 0; k < 4; ++k) { float best = -3.0e38f; int bi = 0;
#pragma unroll
              for (int e = 0; e < NE; ++e) { const bool ok = !((taken >> e) & 1u) && lg[e] > best; best = ok ? lg[e] : best; bi = ok ? e : bi; }
              taken |= 1u << bi; tv[k] = best; te[k] = bi; }
          float p[4], ps = 0.f;
#pragma unroll
          for (int k = 0; k < 4; ++k) { p[k] = __expf(tv[k] - tv[0]); ps += p[k]; }
          const float inv = 1.0f / ps; const int sl = lane & 31;
          if (sl < 4 && r < nrows) {
              const int e = sl == 0 ? te[0] : sl == 1 ? te[1] : sl == 2 ? te[2] : te[3];
              const float pp = (sl == 0 ? p[0] : sl == 1 ? p[1] : sl == 2 ? p[2] : p[3]) * inv;
              const int slot = (k0 + q) * 8 + wave; sel_e[slot * 4 + sl] = e; sel_p[slot * 4 + sl] = pp;
          } }
    }
    __syncthreads();
    const int it = threadIdx.x; int my_e = -1;
    if (it < 160) { my_e = sel_e[it]; if (my_e >= 0) sel_l[it] = __hip_atomic_fetch_add(hist + my_e, 1, __ATOMIC_RELAXED, __HIP_MEMORY_SCOPE_WORKGROUP); }
    __syncthreads();
    if (it < 32) { const int h = hist[it]; base[it] = h ? (int)__hip_atomic_fetch_add(cnt + it * CNT_STRIDE, (unsigned)h, __ATOMIC_RELAXED, __HIP_MEMORY_SCOPE_AGENT) : 0; }
    __syncthreads();
    if (it < 160 && my_e >= 0) { const int slot = it >> 2, sl = it & 3, r = bid * NWAVES + (slot & 7) + (slot >> 3) * ngw, rank = base[my_e] + sel_l[it];
        list[my_e * LCAP + rank] = r; toke[r * 4 + sl] = my_e; tokr[r * 4 + sl] = rank; tokp[r * 4 + sl] = sel_p[it]; }
}
__device__ __forceinline__ void moe_tables(KA a, int layer, LAS int* tpre, LAS int* tcnt) {
    __syncthreads();
    if (threadIdx.x < 64) {
        const unsigned* cnt = (const unsigned*)(a->ws + WS_CTL) + CW_CNT + 32 * layer * CNT_STRIDE; const int e = threadIdx.x & 31;
        const int c = (int)__hip_atomic_load(cnt + e * CNT_STRIDE, __ATOMIC_RELAXED, __HIP_MEMORY_SCOPE_AGENT), tl = (c + 255) >> 8; int inc = tl;
#pragma unroll
        for (int o = 1; o < 32; o <<= 1) { const int v = __shfl_up(inc, o, 32); if (e >= o) inc += v; }
        if (threadIdx.x < 32) { tcnt[e] = c; tpre[e] = inc - tl; if (e == 31) tpre[32] = inc; }
    }
    __syncthreads();
}
__device__ __forceinline__ void phase_combine(KA a, int layer, int nrows, int gw, int ngw, int lane, int tid, LAS unsigned char* lds, const LAS int* tpre) {
    unsigned char* ws = a->ws;
    const float* mv = (const float*)(ws + WS_MODV) + (size_t)layer * 3 * 6 * D; const float* ng = a->in[I_NORMG] + (size_t)layer * 4 * D;
    const bf16_t* YS = (const bf16_t*)(ws + WS_YS + LOFF(layer)); float* XL = (float*)(ws + WS_XL); bf16_t* H = (bf16_t*)(ws + WS_H + LOFF(1));
    const int* toke = (const int*)(ws + WS_TOKE + LOFF(layer)); const int* tokr = (const int*)(ws + WS_TOKR + LOFF(layer)); const float* tokp = (const float*)(ws + WS_TOKP + LOFF(layer));
    LAS float* Lg = (LAS float*)lds;
    LAS float* Lga = Lg + 2 * D;
    LAS float* Lm1 = Lga + 3 * D;
    __syncthreads();
    lds_fill(Lg, ng + 3 * D, layer == 0 ? 2 * D : D, tid);
    for (int mr = 0; mr < 3; ++mr) { lds_fill(Lga + mr * D, mv + (size_t)mr * 6 * D + 5 * D, D, tid); if (layer == 0) lds_fill(Lm1 + mr * 2 * D, mv + (size_t)(3 + mr) * 6 * D, 2 * D, tid); }
    __syncthreads();
    for (int r = gw; r < nrows; r += ngw) {
        const int mr = mod_row(r);
        Row32 y;
#pragma unroll
        for (int i = 0; i < 32; ++i) y.v[i] = 0.f;
#pragma unroll
        for (int k = 0; k < 4; ++k) { const int e = toke[r * 4 + k], rk = tokr[r * 4 + k]; const float p = tokp[r * 4 + k]; const int slot = tpre[e] * 256 + rk;
            Row32 t; load_row_bf16(YS + (size_t)slot * D, lane, t);
#pragma unroll
            for (int i = 0; i < 32; ++i) y.v[i] += p * t.v[i]; }
        Row32 x; load_row_f32(XL + (size_t)r * D, lane, x);
        asm volatile("" ::: "memory");
        { const float rs = row_rstd(y); Row32 g3, ga; load_row_lds(Lg, lane, g3); load_row_lds(Lga + mr * D, lane, ga);
#pragma unroll
          for (int i = 0; i < 32; ++i) x.v[i] += ga.v[i] * (y.v[i] * rs * g3.v[i]); }
        if (layer == 1) { store_row_f32(a->out + (size_t)r * D, lane, x); }
        else {
            store_row_f32(XL + (size_t)r * D, lane, x);
            asm volatile("" ::: "memory");
            const LAS float* m1 = Lm1 + mr * 2 * D;
            Row32 h; norm_mod_l(x, Lg + D, m1 + D, m1, lane, h);
            store_row_bf16(H + (size_t)r * D, lane, h);
        }
    }
    __syncthreads();
}

constexpr int XC_LD = 136;
__device__ __forceinline__ void gmlp_stats(KA a, int gw, int ngw, int lane) {
    const bf16_t* PZ = (const bf16_t*)(a->ws + WS_PZ); float* GST = (float*)(a->ws + WS_GST);
    for (int r = gw; r < NTOK; r += ngw) { const bf16_t* vp = PZ + (size_t)r * 2048 + 1024 + lane * 16;
        const u32x4 w0 = *(const u32x4*)vp, w1 = *(const u32x4*)(vp + 8); float x[16];
        x[0] = bflo(w0.x); x[1] = bfhi(w0.x); x[2] = bflo(w0.y); x[3] = bfhi(w0.y); x[4] = bflo(w0.z); x[5] = bfhi(w0.z); x[6] = bflo(w0.w); x[7] = bfhi(w0.w);
        x[8] = bflo(w1.x); x[9] = bfhi(w1.x); x[10] = bflo(w1.y); x[11] = bfhi(w1.y); x[12] = bflo(w1.z); x[13] = bfhi(w1.z); x[14] = bflo(w1.w); x[15] = bfhi(w1.w);
        float s = 0.f;
#pragma unroll
        for (int j = 0; j < 16; ++j) s += x[j];
        const float mu = wave_sum(s) * (1.0f / 1024.0f); float q2 = 0.f;
#pragma unroll
        for (int j = 0; j < 16; ++j) { const float d = x[j] - mu; q2 += d * d; }
        const float rstd = rsqrtf(wave_sum(q2) * (1.0f / 1024.0f) + EPS);
        if (lane == 0) *(f32x2*)(GST + (size_t)r * 2) = (f32x2){mu, rstd}; }
}
__device__ __forceinline__ void gmlp_unit(KA a, LAS unsigned char* lds, int chunk, int hh, int& cur_hh, int tid, int lane, int wave) {
    const bf16_t* PZ = (const bf16_t*)(a->ws + WS_PZ); bf16_t* MIX = (bf16_t*)(a->ws + WS_MIX);
    LAS bf16_t* wsb = (LAS bf16_t*)lds;
    LAS bf16_t* vnT = (LAS bf16_t*)(lds + 34816);
    LAS float* st = (LAS float*)(lds + MISC_OFF + 1024);
    const int r0 = chunk * 128, fr = lane & 15, fq = lane >> 4;
    __syncthreads();
    if (hh != cur_hh) { const float* wsrc = a->in[I_WS] + (size_t)hh * 128 * 128; cur_hh = hh;
        for (int i = tid; i < 128 * 16; i += NTHR) { const int p = i >> 4, c8 = (i & 15) * 8; const f32x4 w0 = *(const f32x4*)(wsrc + p * 128 + c8), w1 = *(const f32x4*)(wsrc + p * 128 + c8 + 4);
            u32x4 o; o.x = pk2(w0[0], w0[1]); o.y = pk2(w0[2], w0[3]); o.z = pk2(w1[0], w1[1]); o.w = pk2(w1[2], w1[3]); *(LAS u32x4*)(wsb + p * XC_LD + c8) = o; } }
    if (tid < 256) st[tid] = ((const float*)(a->ws + WS_GST))[(size_t)r0 * 2 + tid];
    __syncthreads();
    for (int i = tid; i < 64 * 16; i += NTHR) { const int q = (i & 63) * 2, d0 = (i >> 6) * 8;
        const u32x4 w0 = *(const u32x4*)(PZ + (size_t)(r0 + q) * 2048 + 1024 + hh * 128 + d0), w1 = *(const u32x4*)(PZ + (size_t)(r0 + q + 1) * 2048 + 1024 + hh * 128 + d0);
        const float mu0 = st[2 * q], rs0 = st[2 * q + 1], mu1 = st[2 * q + 2], rs1 = st[2 * q + 3]; const float* vg = a->in[I_VG] + hh * 128 + d0;
        const f32x4 g0 = *(const f32x4*)vg, g1 = *(const f32x4*)(vg + 4);
        LAS unsigned* dp = (LAS unsigned*)(vnT + d0 * XC_LD + q);
        dp[0 * (XC_LD / 2)] = pk2((bflo(w0.x) - mu0) * rs0 * g0[0], (bflo(w1.x) - mu1) * rs1 * g0[0]); dp[1 * (XC_LD / 2)] = pk2((bfhi(w0.x) - mu0) * rs0 * g0[1], (bfhi(w1.x) - mu1) * rs1 * g0[1]);
        dp[2 * (XC_LD / 2)] = pk2((bflo(w0.y) - mu0) * rs0 * g0[2], (bflo(w1.y) - mu1) * rs1 * g0[2]); dp[3 * (XC_LD / 2)] = pk2((bfhi(w0.y) - mu0) * rs0 * g0[3], (bfhi(w1.y) - mu1) * rs1 * g0[3]);
        dp[4 * (XC_LD / 2)] = pk2((bflo(w0.z) - mu0) * rs0 * g1[0], (bflo(w1.z) - mu1) * rs1 * g1[0]); dp[5 * (XC_LD / 2)] = pk2((bfhi(w0.z) - mu0) * rs0 * g1[1], (bfhi(w1.z) - mu1) * rs1 * g1[1]);
        dp[6 * (XC_LD / 2)] = pk2((bflo(w0.w) - mu0) * rs0 * g1[2], (bflo(w1.w) - mu1) * rs1 * g1[2]); dp[7 * (XC_LD / 2)] = pk2((bfhi(w0.w) - mu0) * rs0 * g1[3], (bfhi(w1.w) - mu1) * rs1 * g1[3]); }
    __syncthreads();
    const int wm = wave >> 1, wn = wave & 1;
    f32x4 acc[2][4];
#pragma unroll
    for (int m = 0; m < 2; ++m)
#pragma unroll
        for (int n = 0; n < 4; ++n) acc[m][n] = (f32x4){0.f, 0.f, 0.f, 0.f};
#pragma unroll
    for (int ks = 0; ks < 4; ++ks) { bf16x8 xf[2], yf[4];
#pragma unroll
        for (int m = 0; m < 2; ++m) xf[m] = *(const LAS bf16x8*)(wsb + (32 * wm + 16 * m + fr) * XC_LD + 32 * ks + 8 * fq);
#pragma unroll
        for (int n = 0; n < 4; ++n) yf[n] = *(const LAS bf16x8*)(vnT + (64 * wn + 16 * n + fr) * XC_LD + 32 * ks + 8 * fq);
#pragma unroll
        for (int m = 0; m < 2; ++m)
#pragma unroll
            for (int n = 0; n < 4; ++n) acc[m][n] = __builtin_amdgcn_mfma_f32_16x16x32_bf16(yf[n], xf[m], acc[m][n], 0, 0, 0); }
#pragma unroll
    for (int m = 0; m < 2; ++m) { const int p = 32 * wm + 16 * m + fr; const float bias = a->in[I_BS][hh * 128 + p];
#pragma unroll
        for (int n = 0; n < 4; ++n) { const int d0 = 64 * wn + 16 * n + 4 * fq; const u32x2 uu = *(const u32x2*)(PZ + (size_t)(r0 + p) * 2048 + hh * 128 + d0);
            u32x2 o; o.x = pk2(bflo(uu.x) * (acc[m][n][0] + bias), bfhi(uu.x) * (acc[m][n][1] + bias)); o.y = pk2(bflo(uu.y) * (acc[m][n][2] + bias), bfhi(uu.y) * (acc[m][n][3] + bias));
            *(u32x2*)(MIX + (size_t)(r0 + p) * D + 1024 + hh * 128 + d0) = o; } }
}


constexpr int WP_LD = 136;
__device__ __forceinline__ void fft_unit(KA a, LAS unsigned char* lds, int unit, int tid) {
    const int b = unit >> 7, n0 = (unit & 127) * 8;
    const int lane = tid & 63, wave = __builtin_amdgcn_readfirstlane(tid >> 6), fr = lane & 15, fq = lane >> 4, n = n0 + wave;
    const bf16_t* Z = (const bf16_t*)(a->ws + WS_ZT) + (size_t)(b * 1024 + n) * 64 * 128;
    const bf16_t* FA = (const bf16_t*)(a->ws + WS_FA); const bf16_t* GC = (const bf16_t*)(a->ws + WS_GC);
    LAS bf16_t* wp = (LAS bf16_t*)(lds + wave * (64 * WP_LD * 2));
    __syncthreads();
    bf16x8 yf[4][4];
#pragma unroll
    for (int t = 0; t < 4; ++t)
#pragma unroll
        for (int ks = 0; ks < 4; ++ks) yf[t][ks] = *(const bf16x8*)(Z + (size_t)(16 * t + fr) * 128 + 32 * ks + 8 * fq);
#pragma unroll 1
    for (int aa = 0; aa < 4; ++aa) {
        bf16x8 xr[4], xi[4];
#pragma unroll
        for (int ks = 0; ks < 4; ++ks) { xr[ks] = *(const bf16x8*)(FA + (size_t)(16 * aa + fr) * 128 + 32 * ks + 8 * fq); xi[ks] = *(const bf16x8*)(FA + (size_t)(64 + 16 * aa + fr) * 128 + 32 * ks + 8 * fq); }
#pragma unroll
        for (int t = 0; t < 4; ++t) { f32x4 cr = {0.f, 0.f, 0.f, 0.f}, ci = {0.f, 0.f, 0.f, 0.f};
#pragma unroll
            for (int ks = 0; ks < 4; ++ks) { cr = __builtin_amdgcn_mfma_f32_16x16x32_bf16(yf[t][ks], xr[ks], cr, 0, 0, 0); ci = __builtin_amdgcn_mfma_f32_16x16x32_bf16(yf[t][ks], xi[ks], ci, 0, 0, 0); }
            const int k1 = 16 * aa + fr; float wr4[4], wi4[4];
#pragma unroll
            for (int r = 0; r < 4; ++r) { const int l2 = 16 * t + 4 * fq + r; const float ang = (float)(k1 * l2) * (1.0f / 4096.0f), ct = __builtin_amdgcn_cosf(ang), st = __builtin_amdgcn_sinf(ang);
                wr4[r] = cr[r] * ct + ci[r] * st; wi4[r] = ci[r] * ct - cr[r] * st; }
            u32x2 w; w.x = pk2(wr4[0], wr4[1]); w.y = pk2(wr4[2], wr4[3]); *(LAS u32x2*)(wp + k1 * WP_LD + 16 * t + 4 * fq) = w;
            w.x = pk2(wi4[0], wi4[1]); w.y = pk2(wi4[2], wi4[3]); *(LAS u32x2*)(wp + k1 * WP_LD + 64 + 16 * t + 4 * fq) = w; }
    }
    f32x4 yo[4][4];
#pragma unroll
    for (int aa = 0; aa < 4; ++aa)
#pragma unroll
        for (int c = 0; c < 4; ++c) yo[aa][c] = (f32x4){0.f, 0.f, 0.f, 0.f};
#pragma unroll
    for (int ks = 0; ks < 4; ++ks) { bf16x8 gf[4], wf4[4];
#pragma unroll
        for (int c = 0; c < 4; ++c) gf[c] = *(const bf16x8*)(GC + (size_t)(16 * c + fr) * 128 + 32 * ks + 8 * fq);
#pragma unroll
        for (int aa = 0; aa < 4; ++aa) wf4[aa] = *(const LAS bf16x8*)(wp + (16 * aa + fr) * WP_LD + 32 * ks + 8 * fq);
#pragma unroll
        for (int aa = 0; aa < 4; ++aa)
#pragma unroll
            for (int c = 0; c < 4; ++c) yo[aa][c] = __builtin_amdgcn_mfma_f32_16x16x32_bf16(gf[c], wf4[aa], yo[aa][c], 0, 0, 0); }
    __syncthreads();
    LAS bf16_t* ys = (LAS bf16_t*)lds;
#pragma unroll
    for (int aa = 0; aa < 4; ++aa)
#pragma unroll
        for (int c = 0; c < 4; ++c)
#pragma unroll
            for (int r = 0; r < 4; ++r) { const int k = 16 * aa + fr + 64 * (16 * c + 4 * fq + r); ys[k * 8 + wave] = (bf16_t)(pk2(yo[aa][c][r], 0.f) & 0xffffu); }
    __syncthreads();
    bf16_t* MIX = (bf16_t*)(a->ws + WS_MIX);
#pragma unroll
    for (int q = 0; q < 8; ++q) { const int k = tid + q * NTHR; *(u32x4*)(MIX + (size_t)(b * 4096 + k) * D + n0) = *(const LAS u32x4*)(ys + k * 8); }
}
__device__ __forceinline__ void hgrn_rows(int b, int dir, int c, int& rbase, int& rstep) {
    rstep = dir ? -1 : 1;
    if (c == 0) rbase = NLAT + b * CTXL + (dir ? CTXL - 1 : 0); else rbase = b * SEQ + (dir ? SEQ - 1 - (c - 1) * 256 : (c - 1) * 256);
}
constexpr int VT_LD = 264, ST_LD = 136, KE_LD = 40;
__device__ __forceinline__ void hgrn_stage_vT(const bf16_t* V, LAS bf16_t* vT, int rbase, int rstep, int hh, int tid) {
#pragma unroll 2
    for (int idx = tid; idx < 16 * 128; idx += NTHR) { const int s = (idx & 127) * 2, v0 = (idx >> 7) * 8;
        const u32x4 w0 = *(const u32x4*)(V + (size_t)(rbase + rstep * s) * 1024 + hh * 128 + v0), w1 = *(const u32x4*)(V + (size_t)(rbase + rstep * (s + 1)) * 1024 + hh * 128 + v0);
        LAS unsigned* d = (LAS unsigned*)(vT + v0 * VT_LD + s);
        d[0 * (VT_LD / 2)] = (w0.x & 0xffffu) | (w1.x << 16); d[1 * (VT_LD / 2)] = (w0.x >> 16) | (w1.x & 0xffff0000u);
        d[2 * (VT_LD / 2)] = (w0.y & 0xffffu) | (w1.y << 16); d[3 * (VT_LD / 2)] = (w0.y >> 16) | (w1.y & 0xffff0000u);
        d[4 * (VT_LD / 2)] = (w0.z & 0xffffu) | (w1.z << 16); d[5 * (VT_LD / 2)] = (w0.z >> 16) | (w1.z & 0xffff0000u);
        d[6 * (VT_LD / 2)] = (w0.w & 0xffffu) | (w1.w << 16); d[7 * (VT_LD / 2)] = (w0.w >> 16) | (w1.w & 0xffff0000u); }
}
__device__ __forceinline__ void hgrn_A_unit(KA a, LAS unsigned char* lds, int unit, int tid) {
    const int c = unit & 15, chain = unit >> 4, dir = chain & 1, hh = (chain >> 1) & 7, b = chain >> 4;
    const float* LF = (const float*)(a->ws + WS_LF); const bf16_t* V = (const bf16_t*)(a->ws + WS_V);
    float* ST = (float*)(a->ws + WS_ST) + (size_t)(chain * 16 + c) * 128 * 128; float* DT = (float*)(a->ws + WS_DT) + (size_t)(chain * 16 + c) * 128;
    LAS bf16_t* vT = (LAS bf16_t*)lds; LAS bf16_t* kdT = (LAS bf16_t*)(lds + 67584); LAS float* segsum = (LAS float*)(lds + 135168);
    const int lane = tid & 63, wave = __builtin_amdgcn_readfirstlane(tid >> 6), fr = lane & 15, fq = lane >> 4;
    int rbase, rstep; hgrn_rows(b, dir, c, rbase, rstep);
    __syncthreads();
    hgrn_stage_vT(V, vT, rbase, rstep, hh, tid);
    const int kc = tid & 127, seg = tid >> 7;
    const float* lfp = LF + dir * 1024 + hh * 128 + kc;
    float lfv[64]; float ssum = 0.f;
#pragma unroll
    for (int i = 0; i < 64; ++i) { lfv[i] = lfp[(size_t)(rbase + rstep * (seg * 64 + i)) * 2048]; }
#pragma unroll
    for (int i = 0; i < 64; ++i) ssum += lfv[i];
    segsum[seg * 128 + kc] = ssum;
    __syncthreads();
    { const float s0 = segsum[kc], s1 = segsum[128 + kc], s2 = segsum[256 + kc], s3 = segsum[384 + kc];
      const float total = (s0 + s1) + (s2 + s3); float cum = (seg > 0 ? s0 : 0.f) + (seg > 1 ? s1 : 0.f) + (seg > 2 ? s2 : 0.f);
      if (seg == 0) DT[kc] = __expf(total);
#pragma unroll
      for (int i = 0; i < 64; i += 2) { cum += lfv[i]; const float kd0 = (1.0f - __expf(lfv[i])) * __expf(total - cum); cum += lfv[i + 1]; const float kd1 = (1.0f - __expf(lfv[i + 1])) * __expf(total - cum);
          *(LAS unsigned*)(kdT + kc * VT_LD + seg * 64 + i) = pk2(kd0, kd1); } }
    __syncthreads();
    const int wm = wave >> 1, wn = wave & 1;
    f32x4 acc[2][4];
#pragma unroll
    for (int m = 0; m < 2; ++m)
#pragma unroll
        for (int n = 0; n < 4; ++n) acc[m][n] = (f32x4){0.f, 0.f, 0.f, 0.f};
#pragma unroll 2
    for (int ks = 0; ks < 8; ++ks) {
        bf16x8 vf[2], kf[4];
#pragma unroll
        for (int m = 0; m < 2; ++m) vf[m] = *(const LAS bf16x8*)(vT + (32 * wm + 16 * m + fr) * VT_LD + 32 * ks + 8 * fq);
#pragma unroll
        for (int n = 0; n < 4; ++n) kf[n] = *(const LAS bf16x8*)(kdT + (64 * wn + 16 * n + fr) * VT_LD + 32 * ks + 8 * fq);
#pragma unroll
        for (int m = 0; m < 2; ++m)
#pragma unroll
            for (int n = 0; n < 4; ++n) acc[m][n] = __builtin_amdgcn_mfma_f32_16x16x32_bf16(kf[n], vf[m], acc[m][n], 0, 0, 0);
    }
#pragma unroll
    for (int m = 0; m < 2; ++m)
#pragma unroll
        for (int n = 0; n < 4; ++n) *(f32x4*)(ST + (size_t)(32 * wm + 16 * m + fr) * 128 + 64 * wn + 16 * n + 4 * fq) = acc[m][n];
}
__device__ __forceinline__ void hgrn_B(KA a, int gt, int ngt) {
    for (int idx = gt; idx < 32 * 128 * 32; idx += ngt) {
        const int chain = idx >> 12, rem = idx & 4095, vc = rem >> 5, k4 = (rem & 31) * 4;
        const float* stp = (const float*)(a->ws + WS_ST) + ((size_t)chain * 16 * 128 + vc) * 128 + k4; float* st2 = (float*)(a->ws + WS_ST2) + ((size_t)chain * 16 * 128 + vc) * 128 + k4; const float* dtp = (const float*)(a->ws + WS_DT) + (size_t)chain * 16 * 128 + k4;
        f32x4 U[16], Dv[16];
#pragma unroll
        for (int c = 0; c < 16; ++c) { U[c] = *(const f32x4*)(stp + (size_t)c * 128 * 128); Dv[c] = *(const f32x4*)(dtp + c * 128); }
        f32x4 S = {0.f, 0.f, 0.f, 0.f};
#pragma unroll
        for (int c = 0; c < 16; ++c) { S = Dv[c] * S + U[c]; *(f32x4*)(st2 + (size_t)c * 128 * 128) = S; }
    }
}
__device__ __forceinline__ void hgrn_C_unit(KA a, LAS unsigned char* lds, int unit, int tid) {
    const int cl = unit & 15, hh = (unit >> 4) & 7, b = unit >> 7, r0 = b * SEQ + cl * 256;
    const float* LF = (const float*)(a->ws + WS_LF); const bf16_t* V = (const bf16_t*)(a->ws + WS_V); const bf16_t* Q = (const bf16_t*)(a->ws + WS_Q);
    LAS bf16_t* vT = (LAS bf16_t*)lds;
    LAS bf16_t* sT = (LAS bf16_t*)(lds + 67584);
    LAS bf16_t* qd = (LAS bf16_t*)(lds + 102400);
    LAS bf16_t* ki = (LAS bf16_t*)(lds + 111104);
    LAS bf16_t* keT = (LAS bf16_t*)(lds + 119808);
    LAS bf16_t* sc = (LAS bf16_t*)(lds + 130048);
    LAS float* de = (LAS float*)(lds + 132608);
    LAS float* ssq = (LAS float*)(lds + 133120);
    const int lane = tid & 63, wave = __builtin_amdgcn_readfirstlane(tid >> 6), fr = lane & 15, fq = lane >> 4;
    __syncthreads();
    hgrn_stage_vT(V, vT, r0, 1, hh, tid);
    const int kc0 = (wave * 8 + (lane & 7)) * 2, part = lane >> 3;
    f32x4 osum[8][2];
    f32x2 lfN[4]; unsigned qN[4];
#define HC_ISSUE(dirn, jbn) do { _Pragma("unroll") for (int t = 0; t < 4; ++t) { const int row = r0 + 32 * (jbn) + 4 * part + t; \
        lfN[t] = *(const f32x2*)(LF + (size_t)row * 2048 + (dirn) * 1024 + hh * 128 + kc0); qN[t] = *(const unsigned*)(Q + (size_t)row * 1024 + hh * 128 + kc0); } } while (0)
#define HC_BAR() asm volatile("s_waitcnt lgkmcnt(0)\n\ts_barrier" ::: "memory")
    HC_ISSUE(0, 0);
#pragma unroll 1
    for (int dir = 0; dir < 2; ++dir) {
        const int chain = (b * 8 + hh) * 2 + dir, slot = dir ? 15 - cl : cl;
        f32x4 Sacc[8];
        { const float* stp = (const float*)(a->ws + WS_ST2) + ((size_t)(chain * 16 + slot) * 128 + 16 * wave + fr) * 128 + 4 * fq;
#pragma unroll
          for (int n = 0; n < 8; ++n) { Sacc[n] = *(const f32x4*)(stp + 16 * n); u32x2 w; w.x = pk2(Sacc[n][0], Sacc[n][1]); w.y = pk2(Sacc[n][2], Sacc[n][3]); *(LAS u32x2*)(sT + (16 * wave + fr) * ST_LD + 16 * n + 4 * fq) = w; } }
#pragma unroll
        for (int j = 0; j < 8; ++j) {
            const int jb = dir ? 7 - j : j;
            { f32x2 lf[4]; float qx[4], qy[4];
#pragma unroll
              for (int t = 0; t < 4; ++t) { lf[t] = lfN[t]; const unsigned qw = qN[t]; qx[t] = bflo(qw); qy[t] = bfhi(qw); }
              asm volatile("" ::: "memory");
              if (j < 7) HC_ISSUE(dir, dir ? 6 - j : j + 1); else if (dir == 0) HC_ISSUE(1, 7);
              asm volatile("" ::: "memory");
              f32x2 p[4], run = {0.f, 0.f};
#pragma unroll
              for (int t = 0; t < 4; ++t) { run += lf[t]; p[t] = run; }
              f32x2 off = {0.f, 0.f}, total = {0.f, 0.f};
#pragma unroll
              for (int q = 0; q < 8; ++q) { const float sx = __shfl(run.x, (lane & 7) + 8 * q), sy = __shfl(run.y, (lane & 7) + 8 * q); total.x += sx; total.y += sy; if (q < part) { off.x += sx; off.y += sy; } }
              float kex[4], key[4];
#pragma unroll
              for (int t = 0; t < 4; ++t) {
                  const float clx = dir ? total.x - (off.x + p[t].x) + lf[t].x : off.x + p[t].x, cly = dir ? total.y - (off.y + p[t].y) + lf[t].y : off.y + p[t].y;
                  const float kx = 1.0f - __expf(lf[t].x), ky = 1.0f - __expf(lf[t].y); const int i = 4 * part + t;
                  *(LAS unsigned*)(qd + i * ST_LD + kc0) = pk2(qx[t] * __expf(clx), qy[t] * __expf(cly)); *(LAS unsigned*)(ki + i * ST_LD + kc0) = pk2(kx * __expf(-clx), ky * __expf(-cly));
                  kex[t] = kx * __expf(total.x - clx); key[t] = ky * __expf(total.y - cly); }
              { u32x2 w; w.x = pk2(kex[0], kex[1]); w.y = pk2(kex[2], kex[3]); *(LAS u32x2*)(keT + kc0 * KE_LD + 4 * part) = w; w.x = pk2(key[0], key[1]); w.y = pk2(key[2], key[3]); *(LAS u32x2*)(keT + (kc0 + 1) * KE_LD + 4 * part) = w; }
              if (part == 0) *(LAS f32x2*)(de + kc0) = (f32x2){__expf(total.x), __expf(total.y)}; }
            HC_BAR();
            f32x4 o[2] = {(f32x4){0.f, 0.f, 0.f, 0.f}, (f32x4){0.f, 0.f, 0.f, 0.f}};
#pragma unroll
            for (int ks = 0; ks < 4; ++ks) { const bf16x8 sf = *(const LAS bf16x8*)(sT + (16 * wave + fr) * ST_LD + 32 * ks + 8 * fq);
#pragma unroll
                for (int mi = 0; mi < 2; ++mi) { const bf16x8 qf = *(const LAS bf16x8*)(qd + (16 * mi + fr) * ST_LD + 32 * ks + 8 * fq); o[mi] = __builtin_amdgcn_mfma_f32_16x16x32_bf16(sf, qf, o[mi], 0, 0, 0); } }
            if (wave < 4) { const int mi = wave >> 1, ni = wave & 1; f32x4 sa = {0.f, 0.f, 0.f, 0.f};
#pragma unroll
                for (int ks = 0; ks < 4; ++ks) { const bf16x8 kf = *(const LAS bf16x8*)(ki + (16 * ni + fr) * ST_LD + 32 * ks + 8 * fq), qf = *(const LAS bf16x8*)(qd + (16 * mi + fr) * ST_LD + 32 * ks + 8 * fq);
                    sa = __builtin_amdgcn_mfma_f32_16x16x32_bf16(kf, qf, sa, 0, 0, 0); }
                const int ii = 16 * mi + fr, jp = 16 * ni + 4 * fq; u32x2 w;
                const bool k0 = dir ? (jp + 0 >= ii) : (jp + 0 <= ii), k1 = dir ? (jp + 1 >= ii) : (jp + 1 <= ii), k2 = dir ? (jp + 2 >= ii) : (jp + 2 <= ii), k3 = dir ? (jp + 3 >= ii) : (jp + 3 <= ii);
                w.x = pk2(k0 ? sa[0] : 0.f, k1 ? sa[1] : 0.f); w.y = pk2(k2 ? sa[2] : 0.f, k3 ? sa[3] : 0.f);
                *(LAS u32x2*)(sc + ii * KE_LD + jp) = w; }
            HC_BAR();
            { const bf16x8 vf = *(const LAS bf16x8*)(vT + (16 * wave + fr) * VT_LD + 32 * jb + 8 * fq);
#pragma unroll
              for (int mi = 0; mi < 2; ++mi) { const bf16x8 sf2 = *(const LAS bf16x8*)(sc + (16 * mi + fr) * KE_LD + 8 * fq); o[mi] = __builtin_amdgcn_mfma_f32_16x16x32_bf16(vf, sf2, o[mi], 0, 0, 0); }
              if (dir == 0) { osum[j][0] = o[0]; osum[j][1] = o[1]; } else { osum[7 - j][0] += o[0]; osum[7 - j][1] += o[1]; }
#pragma unroll
              for (int n = 0; n < 8; ++n) { const f32x4 d4 = *(const LAS f32x4*)(de + 16 * n + 4 * fq); const bf16x8 kf = *(const LAS bf16x8*)(keT + (16 * n + fr) * KE_LD + 8 * fq);
                  Sacc[n] = Sacc[n] * d4; Sacc[n] = __builtin_amdgcn_mfma_f32_16x16x32_bf16(kf, vf, Sacc[n], 0, 0, 0);
                  u32x2 w; w.x = pk2(Sacc[n][0], Sacc[n][1]); w.y = pk2(Sacc[n][2], Sacc[n][3]); *(LAS u32x2*)(sT + (16 * wave + fr) * ST_LD + 16 * n + 4 * fq) = w; } }
            HC_BAR();
        }
    }
#pragma unroll
    for (int jb = 0; jb < 8; ++jb)
#pragma unroll
        for (int mi = 0; mi < 2; ++mi) { const f32x4 v = osum[jb][mi]; float s = (v[0] * v[0] + v[1] * v[1]) + (v[2] * v[2] + v[3] * v[3]); s += __shfl_xor(s, 16); s += __shfl_xor(s, 32);
            if (fq == 0) ssq[(32 * jb + 16 * mi + fr) * 8 + wave] = s; }
    __syncthreads();
    { const bf16_t* G = (const bf16_t*)(a->ws + WS_G); bf16_t* MIX = (bf16_t*)(a->ws + WS_MIX + LOFF(1)); const int vc0 = hh * 128 + 16 * wave + 4 * fq;
      const f32x4 on = *(const f32x4*)(a->in[I_ONORM] + vc0);
#pragma unroll
      for (int jb = 0; jb < 8; ++jb)
#pragma unroll
          for (int mi = 0; mi < 2; ++mi) { const int t = 32 * jb + 16 * mi + fr; const f32x4 s0 = *(const LAS f32x4*)(ssq + t * 8), s1 = *(const LAS f32x4*)(ssq + t * 8 + 4);
              const float rs = rsqrtf(((s0[0] + s0[1]) + (s0[2] + s0[3]) + (s1[0] + s1[1]) + (s1[2] + s1[3])) * (1.0f / 128.0f) + EPS);
              const u32x2 gw = *(const u32x2*)(G + (size_t)(r0 + t) * 1024 + vc0); const f32x4 v = osum[jb][mi];
              u32x2 w; w.x = pk2(v[0] * rs * on[0] * bflo(gw.x), v[1] * rs * on[1] * bfhi(gw.x)); w.y = pk2(v[2] * rs * on[2] * bflo(gw.y), v[3] * rs * on[3] * bfhi(gw.y));
              *(u32x2*)(MIX + (size_t)(r0 + t) * D + vc0) = w; } }
}
__device__ __forceinline__ int lru_tile(int b, int dir, int p) { return p < 4 ? 128 + 4 * b + (dir ? 3 - p : p) : 64 * b + (dir ? 63 - (p - 4) : p - 4); }
struct LruW { bf16x8 f[2][2][4]; };
__device__ __forceinline__ void lru_A_unit(KA a, LAS unsigned char* lds, int unit, int tid, LruW& wf, int& cur_hh) {
    const int hh = unit & 7, tl = unit >> 3, r0 = tl * 64;
    const bf16_t* LX = (const bf16_t*)(a->ws + WS_LX);
    LAS bf16_t* xcb = (LAS bf16_t*)lds;
    const int lane = tid & 63, wave = __builtin_amdgcn_readfirstlane(tid >> 6), fr = lane & 15, fq = lane >> 4;
    const int seq0 = r0 < NLAT ? (r0 & ~(SEQ - 1)) : NLAT + ((r0 - NLAT) & ~(CTXL - 1)), seqlen = r0 < NLAT ? SEQ : CTXL;
    if (hh != cur_hh) { cur_hh = hh;
#pragma unroll
        for (int dm = 0; dm < 4; ++dm)
#pragma unroll
            for (int ks = 0; ks < 4; ++ks) wf.f[dm >> 1][dm & 1][ks] = *(const bf16x8*)((const bf16_t*)(a->ws + WS_WRT) + ((size_t)(dm * 8 + hh) * 128 + 16 * wave + fr) * 128 + 32 * ks + 8 * fq); }
    __syncthreads();
    {
        const int c = (tid & 63) * 2, t0 = (tid >> 6) * 8, ch2 = hh * 128 + c, pos0 = r0 + t0 - seq0;
        f32x2 cw[4];
#pragma unroll
        for (int jj = 0; jj < 4; ++jj) cw[jj] = *(const f32x2*)(a->in[I_CONVW] + jj * 1024 + ch2);
        const f32x2 cb = *(const f32x2*)(a->in[I_CONVB] + ch2);
        float x0[11], x1[11];
#pragma unroll
        for (int q = 0; q < 11; ++q) { const int p = pos0 + q - 2; unsigned w = 0u; if (p >= 0 && p < seqlen) w = *(const unsigned*)(LX + (size_t)(seq0 + p) * 1024 + ch2); x0[q] = bflo(w); x1[q] = bfhi(w); }
#pragma unroll
        for (int q = 0; q < 8; ++q) { float s0 = cb.x, s1 = cb.y;
#pragma unroll
            for (int jj = 0; jj < 4; ++jj) { s0 += cw[jj].x * x0[q + jj]; s1 += cw[jj].y * x1[q + jj]; }
            *(LAS unsigned*)(xcb + (t0 + q) * XC_LD + c) = pk2(s0, s1); }
    }
    __syncthreads();
    const int j = 16 * wave + fr, ch = hh * 128 + j;
    LAS bf16_t* las = (LAS bf16_t*)(lds + 17408); LAS bf16_t* lus = (LAS bf16_t*)(lds + 33792);
    bf16x8 af[4][4];
#pragma unroll
    for (int ks = 0; ks < 4; ++ks)
#pragma unroll
        for (int m = 0; m < 4; ++m) af[ks][m] = *(const LAS bf16x8*)(xcb + (16 * m + fr) * XC_LD + 32 * ks + 8 * fq);
    float xcv[4][4];
#pragma unroll
    for (int m = 0; m < 4; ++m)
#pragma unroll
        for (int r = 0; r < 4; ++r) xcv[m][r] = bf1(xcb[(16 * m + 4 * fq + r) * XC_LD + j]);
#pragma unroll
    for (int dir = 0; dir < 2; ++dir) {
        f32x4 acc[2][4];
#pragma unroll
        for (int mat = 0; mat < 2; ++mat)
#pragma unroll
            for (int m = 0; m < 4; ++m) { acc[mat][m] = (f32x4){0.f, 0.f, 0.f, 0.f};
#pragma unroll
                for (int ks = 0; ks < 4; ++ks) acc[mat][m] = __builtin_amdgcn_mfma_f32_16x16x32_bf16(af[ks][m], wf.f[dir][mat][ks], acc[mat][m], 0, 0, 0); }
        const float br = a->in[I_BR][dir * 1024 + ch], bi = a->in[I_BI][dir * 1024 + ch]; const float el = __expf(-a->in[I_LAM][dir * 1024 + ch]), sp = el < 0.03f ? el * (1.0f - el * (0.5f - el * (1.0f / 3.0f))) : __logf(1.0f + el);
        float la[4][4], uu[4][4], g[4];
#pragma unroll
        for (int m = 0; m < 4; ++m) { g[m] = 0.f;
#pragma unroll
            for (int r = 0; r < 4; ++r) { const int t = 16 * m + 4 * fq + r; const float rg = sigmoidf_(acc[0][m][r] + br), ig = sigmoidf_(acc[1][m][r] + bi); la[m][r] = -8.0f * rg * sp;
                uu[m][r] = sqrtf(1.0f - __expf(2.0f * la[m][r])) * (ig * xcv[m][r]); g[m] += la[m][r];
                las[t * 128 + j] = (bf16_t)(pk2(la[m][r], 0.f) & 0xffffu); lus[t * 128 + j] = (bf16_t)(pk2(uu[m][r], 0.f) & 0xffffu); } }
        float P = 0.f, X[4];
#pragma unroll
        for (int m = 0; m < 4; ++m) { X[m] = P;
#pragma unroll
            for (int f = 0; f < 4; ++f) { const float gv = __shfl(g[m], fr + 16 * f); if (f < fq) X[m] += gv; P += gv; } }
        float E = 0.f;
#pragma unroll
        for (int m = 0; m < 4; ++m) { float c = X[m];
#pragma unroll
            for (int r = 0; r < 4; ++r) { c += la[m][r]; E += uu[m][r] * __expf(dir == 0 ? (P - c) : (c - la[m][r])); } }
        E += __shfl_xor(E, 16); E += __shfl_xor(E, 32);
        if (fq == 0) { ((float*)(a->ws + WS_PS))[((size_t)dir * 136 + tl) * 1024 + ch] = P; ((float*)(a->ws + WS_ES))[((size_t)dir * 136 + tl) * 1024 + ch] = E; }
        __syncthreads();
        { bf16_t* LA = (bf16_t*)(a->ws + WS_LA) + (size_t)dir * NTOK * 1024; bf16_t* LU = (bf16_t*)(a->ws + WS_LU) + (size_t)dir * NTOK * 1024;
#pragma unroll
          for (int q = 0; q < 2; ++q) { const int i = tid + q * NTHR, t = i >> 4, c8 = (i & 15) * 8;
              *(u32x4*)(LA + (size_t)(r0 + t) * 1024 + hh * 128 + c8) = *(const LAS u32x4*)(las + t * 128 + c8); *(u32x4*)(LU + (size_t)(r0 + t) * 1024 + hh * 128 + c8) = *(const LAS u32x4*)(lus + t * 128 + c8); } }
        if (dir == 0) __syncthreads();
    }
}
__device__ __forceinline__ void lru_B(KA a, int gt) {
    if (gt >= NB * 2 * 1024) return;
    const int ch = gt & 1023, dir = (gt >> 10) & 1, b = gt >> 11;
    const float* PS = (const float*)(a->ws + WS_PS) + (size_t)dir * 136 * 1024 + ch; const float* ES = (const float*)(a->ws + WS_ES) + (size_t)dir * 136 * 1024 + ch;
    float* HI = (float*)(a->ws + WS_HI) + (size_t)dir * 136 * 1024 + ch;
    float h = 0.f;
#pragma unroll 17
    for (int p = 0; p < 68; ++p) { const int tl = lru_tile(b, dir, p); HI[(size_t)tl * 1024] = h; h = __expf(PS[(size_t)tl * 1024]) * h + ES[(size_t)tl * 1024]; }
}
__device__ __forceinline__ void lru_C(KA a, LAS unsigned char* lds, int tid, int bid, int G) {
    const bf16_t* LG = (const bf16_t*)(a->ws + WS_LG); bf16_t* MIX = (bf16_t*)(a->ws + WS_MIX + LOFF(1));
    LAS f32x2* hfs = (LAS f32x2*)lds;
    const int cp = tid & 255, role = tid >> 8;
    for (int item = bid; item < 256; item += G) {
        const int tl = item >> 1, ch = (item & 1) * 512 + 2 * cp, r0 = tl * 64;
        __syncthreads();
        if (role == 0) {
            const bf16_t* la = (const bf16_t*)(a->ws + WS_LA) + (size_t)r0 * 1024 + ch; const bf16_t* lu = (const bf16_t*)(a->ws + WS_LU) + (size_t)r0 * 1024 + ch;
            f32x2 h = *(const f32x2*)((const float*)(a->ws + WS_HI) + (size_t)tl * 1024 + ch);
#pragma unroll 16
            for (int t = 0; t < 64; ++t) { const unsigned wa = *(const unsigned*)la, wu = *(const unsigned*)lu; la += 1024; lu += 1024;
                h.x = __expf(bflo(wa)) * h.x + bflo(wu); h.y = __expf(bfhi(wa)) * h.y + bfhi(wu); hfs[t * 256 + cp] = h; }
            __syncthreads();
        } else {
            const bf16_t* la = (const bf16_t*)(a->ws + WS_LA) + (size_t)(NTOK + r0 + 63) * 1024 + ch; const bf16_t* lu = (const bf16_t*)(a->ws + WS_LU) + (size_t)(NTOK + r0 + 63) * 1024 + ch;
            f32x2 h = *(const f32x2*)((const float*)(a->ws + WS_HI) + (size_t)(136 + tl) * 1024 + ch);
            f32x2 hb[64];
#pragma unroll
            for (int t = 63; t >= 0; --t) { const unsigned wa = *(const unsigned*)la, wu = *(const unsigned*)lu; la -= 1024; lu -= 1024;
                h.x = __expf(bflo(wa)) * h.x + bflo(wu); h.y = __expf(bfhi(wa)) * h.y + bfhi(wu); hb[t] = h; if ((t & 15) == 0) asm volatile("" ::: "memory"); }
            __syncthreads();
            const bf16_t* lg = LG + (size_t)r0 * 1024 + ch; bf16_t* mx = MIX + (size_t)r0 * D + 1024 + ch;
#pragma unroll
            for (int t = 0; t < 64; ++t) { const f32x2 hf = hfs[t * 256 + cp]; const unsigned wg = *(const unsigned*)(lg + (size_t)t * 1024);
                *(unsigned*)(mx + (size_t)t * D) = pk2((hf.x + hb[t].x) * bflo(wg), (hf.y + hb[t].y) * bfhi(wg)); if ((t & 15) == 15) asm volatile("" ::: "memory"); }
        }
    }
}
#ifndef PHMASK
#define PHMASK 0x1FFFFFu
#endif
#define HAS(k) (((PHMASK) >> (k)) & 1u)
#define IN(k) (HAS(k) && lo <= (k) && (k) < hi)
#define SEAM(k) do { if (lo <= (k) && (k) + 1 < hi) xcd_barrier(bar); } while (0)
#define LAUNDER() int tid = wave * 64 + (int)__builtin_amdgcn_mbcnt_hi(~0u, __builtin_amdgcn_mbcnt_lo(~0u, 0u)); asm volatile("" : "+v"(tid)); int G = G0, bid = bid0; asm volatile("" : "+s"(G), "+s"(bid)); const int lane = tid & 63, gt = bid * NTHR + tid, gw = bid * NWAVES + wave, ngw = G * NWAVES, ngt = G * NTHR; (void)lane; (void)gt; (void)gw; (void)ngw; (void)ngt
template <int LAYER>
__device__ __forceinline__ void shared_phases(LAS unsigned char* lds, const int lo, const int hi, const XcdBarrier& bar, LAS int* tpre, LAS int* tcnt, const int wave, const int G0, const int bid0) {
    constexpr int layer = LAYER, sb = LAYER == 0 ? 6 : 15;
    constexpr int nrows = LAYER == 0 ? NTOK : NLAT;
    if (HAS(6) && lo <= sb && sb < hi) {
        LAUNDER(); KA a = get_args(); unsigned char* ws = a->ws;
        pg8::SchedPlain S{(const char*)(ws + WS_MIX + LOFF(layer)), (const char*)(ws + WS_WOUT) + (size_t)layer * D * D * 2, D, D, nrows / 256, D / 256, D, G, bid};
        EpiRaw E{(bf16_t*)(ws + WS_O + LOFF(layer)), D};
        pg8::gemm_phase<EpiRaw, pg8::SchedPlain, false>(lds, S, E, tid);
        if (LAYER == 0 && G == 256 && bid >= FILL6_B0) { const int base = TR_NIT - TR_F6 + (bid - FILL6_B0) * 8 * FILL6_PERW; tr_run(a, ws, base + wave, base + 8 * FILL6_PERW, 8, lane); }
    } SEAM(sb);
    if (HAS(7) && lo <= sb + 1 && sb + 1 < hi) { LAUNDER(); KA a = get_args(); phase_row1(a, layer, nrows, bid, G, wave, lane, lds); __syncthreads(); } SEAM(sb + 1);
    if (HAS(8) && lo <= sb + 2 && sb + 2 < hi) {
        LAUNDER(); KA a = get_args(); unsigned char* ws = a->ws;
        moe_tables(a, layer, tpre, tcnt);
        SchedGU S{(const char*)(ws + WS_H2 + LOFF(layer)), (const char*)(ws + WS_WGU) + (size_t)layer * NE * 2048 * D * 2, (const int*)(ws + WS_LIST + LOFF(layer)), tpre, tcnt, D, 64, G, bid};
        EpiGU E{(bf16_t*)(ws + WS_ACT + LOFF(layer)), a->in[I_BGU] + (size_t)layer * NE * 2048};
        pg8::gemm_phase<EpiGU, SchedGU, true>(lds, S, E, tid);
    } SEAM(sb + 2);
    if (HAS(9) && lo <= sb + 3 && sb + 3 < hi) {
        LAUNDER(); KA a = get_args(); unsigned char* ws = a->ws;
        moe_tables(a, layer, tpre, tcnt);
        SchedDown S{(const char*)(ws + WS_ACT + LOFF(layer)), (const char*)(ws + WS_WDN) + (size_t)layer * NE * D * DE * 2, tpre, tcnt, 64, 64, G, bid};
        EpiDown E{(bf16_t*)(ws + WS_YS + LOFF(layer)), a->in[I_BDN] + (size_t)layer * NE * D};
        pg8::gemm_phase<EpiDown, SchedDown, false>(lds, S, E, tid);
    } SEAM(sb + 3);
    if (HAS(10) && lo <= sb + 4 && sb + 4 < hi) { LAUNDER(); KA a = get_args(); moe_tables(a, layer, tpre, tcnt); phase_combine(a, layer, nrows, gw, ngw, lane, tid, lds, tpre); } SEAM(sb + 4);
}

__global__ void __launch_bounds__(NTHR, 2) fwd(Args args_unused) {
    extern __shared__ __attribute__((aligned(16))) unsigned char smem[];
    LAS unsigned char* lds = (LAS unsigned char*)smem;
    const int tid0 = threadIdx.x, wave = __builtin_amdgcn_readfirstlane(tid0 >> 6);
    const int G0 = gridDim.x, bid0 = blockIdx.x;
    volatile LAS unsigned* MISC = (volatile LAS unsigned*)(lds + MISC_OFF);
    LAS int* tpre = (LAS int*)(lds + MISC_OFF + 64); LAS int* tcnt = (LAS int*)(lds + MISC_OFF + 64 + 256);
    if (tid0 < 4) MISC[tid0] = 0u;
    __syncthreads();
    int lo, hi; XcdBarrier bar;
    { KA a = get_args(); lo = a->ph_lo; hi = a->ph_hi; bar.bar = (unsigned*)(a->ws + WS_CTL) + CW_BAR; bar.x = 0; bar.st = MISC;
      if (hi - lo > 1) bar = xcd_barrier_post((unsigned*)(a->ws + WS_CTL) + CW_BAR, MISC); }
#define SEAM(k) do { if (lo <= (k) && (k) + 1 < hi) xcd_barrier(bar); } while (0)

    if (IN(0)) { LAUNDER(); KA a = get_args(); phase_prologue(a, gw, ngw, lane);    } SEAM(0);
    if (IN(1)) { LAUNDER(); KA a = get_args(); phase_modfinal(a, gt, ngt);    } SEAM(1);
    if (IN(2)) { LAUNDER(); KA a = get_args(); phase_h0(a, gw, ngw, lane, tid, lds);    } SEAM(2);

    if (IN(3)) {
        LAUNDER(); KA a = get_args(); unsigned char* ws = a->ws;
        pg8::SchedPlain S{(const char*)(ws + WS_H), (const char*)(ws + WS_WABIN), D, D, NTOK / 256, AB_COLS / 256, D, G, bid};
        EpiAbIn E{(bf16_t*)(ws + WS_PA), (bf16_t*)(ws + WS_PZ)};
        pg8::gemm_phase<EpiAbIn, pg8::SchedPlain, false>(lds, S, E, tid);
        if (G == 256 && bid >= FILL3_B0) { const int base = TR_NIT - TR_F6 - TR_F3 + (bid - FILL3_B0) * 8 * FILL3_PERW; tr_run(a, ws, base + wave, base + 8 * FILL3_PERW, 8, lane); }
    } SEAM(3);
    if (IN(4)) {
        LAUNDER(); KA a = get_args(); unsigned char* ws = a->ws;
        { SchedChan S{(const char*)(ws + WS_F256), (const char*)(ws + WS_PA), 256, 1024, G, bid}; EpiChan E{(bf16_t*)(ws + WS_ZT)};
          pg8::gemm_phase<EpiChan, SchedChan, false>(lds, S, E, tid); }
        { SchedChanC S{(const char*)(ws + WS_F256), (const char*)(ws + WS_PA), 256, 1024, G, (bid + 16) % G}; EpiChanC E{(bf16_t*)(ws + WS_ZTC)};
          pg8::gemm_phase<EpiChanC, SchedChanC, false>(lds, S, E, tid); }
        gmlp_stats(a, gw, ngw, lane);
        __syncthreads();
    } SEAM(4);
    if (IN(5)) {
        LAUNDER(); KA a = get_args(); unsigned char* ws = a->ws;
        for (int u = bid; u < 256; u += G) fft_unit(a, lds, u, tid);
        __syncthreads();
        { SchedPosC S{(const char*)(ws + WS_DLC), (const char*)(ws + WS_ZTC), 512, 512, G, (bid + 128) % G}; EpiPos E{(bf16_t*)(ws + WS_MIX)};
          pg8::gemm_phase<EpiPos, SchedPosC, false>(lds, S, E, tid); }
        { int cur_hh = -1; for (int u = bid; u < 68 * 8; u += G) gmlp_unit(a, lds, u >> 3, u & 7, cur_hh, tid, lane, wave);
          __syncthreads(); }
    } SEAM(5);

    shared_phases<0>(lds, lo, hi, bar, tpre, tcnt, wave, G0, bid0);
    if (IN(11)) {
        LAUNDER(); KA a = get_args(); unsigned char* ws = a->ws;
        pg8::SchedPlain S{(const char*)(ws + WS_H + LOFF(1)), (const char*)(ws + WS_WCDIN), D, D, NTOK / 256, CD_COLS / 256, D, G, bid};
        EpiCdIn E{(bf16_t*)(ws + WS_Q), (bf16_t*)(ws + WS_V), (bf16_t*)(ws + WS_G), (bf16_t*)(ws + WS_LG), (bf16_t*)(ws + WS_LX), (float*)(ws + WS_LF), a->in[I_LB]};
        pg8::gemm_phase<EpiCdIn, pg8::SchedPlain, false>(lds, S, E, tid);
        if (G == 256 && bid >= FILL11_B0) { const int base = TR_NIT - TR_FILL + (bid - FILL11_B0) * 8 * FILL11_PERW; tr_run(a, ws, base + wave, base + 8 * FILL11_PERW, 8, lane); }
    } SEAM(11);
    if (IN(12)) {
        LAUNDER(); KA a = get_args();
        for (int u = bid; u < 512; u += G) hgrn_A_unit(a, lds, u, tid);
        { LruW wf; int cur_hh = -1; for (int u = bid; u < (NTOK / 64) * 8; u += G) lru_A_unit(a, lds, u, tid, wf, cur_hh); }
        __syncthreads();
    } SEAM(12);
    if (IN(13)) { LAUNDER(); KA a = get_args(); hgrn_B(a, gt, ngt); lru_B(a, gt);    } SEAM(13);
    if (IN(14)) {
        LAUNDER(); KA a = get_args();
        for (int u = bid; u < 256; u += G) hgrn_C_unit(a, lds, u, tid);
        __syncthreads();
        lru_C(a, lds, tid, bid, G);
    } SEAM(14);

    shared_phases<1>(lds, lo, hi, bar, tpre, tcnt, wave, G0, bid0);
#undef IN
#undef SEAM
}

#ifndef N_LAUNCH_MODE
#define N_LAUNCH_MODE 1
#endif
extern "C" void kernel_launch(void* const* d_in, const int* in_sizes, int n_in, void* d_out, int out_size, void* d_ws, size_t ws_size, hipStream_t stream) {
    static int grid = 0;
    if (grid == 0) {
        if (n_in != 29 || out_size != NLAT * D || ws_size < WS_END) { fprintf(stderr, "kernel_launch: unexpected shapes (n_in %d out %d ws %zu need %zu)\n", n_in, out_size, ws_size, (size_t)WS_END); grid = -1; return; }
        int dev = 0, cus = 0, per_cu = 0;
        if (hipGetDevice(&dev) != hipSuccess || hipDeviceGetAttribute(&cus, hipDeviceAttributeMultiprocessorCount, dev) != hipSuccess) { grid = -1; return; }
        if (hipFuncSetAttribute((const void*)fwd, hipFuncAttributeMaxDynamicSharedMemorySize, LDS_BYTES) != hipSuccess) { fprintf(stderr, "kernel_launch: hipFuncSetAttribute failed\n"); grid = -1; return; }
        if (hipOccupancyMaxActiveBlocksPerMultiprocessor(&per_cu, (const void*)fwd, NTHR, LDS_BYTES) != hipSuccess || per_cu < 1) fprintf(stderr, "kernel_launch: occupancy query reports %d\n", per_cu);
        (void)hipGetLastError();
        grid = cus;
    }
    if (grid < 0) return;
    (void)hipMemsetAsync((char*)d_ws + WS_CTL, 0, CTL_BYTES, stream);
    Args a{};
    for (int i = 0; i < 29; ++i) a.in[i] = (const float*)d_in[i];
    a.out = (float*)d_out; a.ws = (unsigned char*)d_ws;
#if N_LAUNCH_MODE == 1
    a.ph_lo = 0; a.ph_hi = NPH;
    hipLaunchKernelGGL(fwd, dim3(grid), dim3(NTHR), LDS_BYTES, stream, a);
#else
    for (int p = 0; p < NPH; ++p) { a.ph_lo = p; a.ph_hi = p + 1; hipLaunchKernelGGL(fwd, dim3(grid), dim3(NTHR), LDS_BYTES, stream, a); }
#endif
    const hipError_t le = hipPeekAtLastError();
    if (le != hipSuccess) fprintf(stderr, "kernel_launch: launch failed: %s\n", hipGetErrorName(le));
}
```

```cpp
#include <hip/hip_runtime.h>
#include <cstdio>
#include <cstdint>

#define LAS __attribute__((address_space(3)))
typedef unsigned short bf16_t;
typedef short bf16x8 __attribute__((ext_vector_type(8)));
typedef float f32x4 __attribute__((ext_vector_type(4)));
typedef float f32x2 __attribute__((ext_vector_type(2)));
typedef unsigned u32x4 __attribute__((ext_vector_type(4)));
typedef unsigned u32x2 __attribute__((ext_vector_type(2)));

constexpr int D = 2048, NB = 2, SEQ = 4096, CTXL = 256, NLAT = NB * SEQ, NCTX = NB * CTXL, NTOK = NLAT + NCTX;
constexpr int NE = 32, DE = 1024, LCAP = NTOK;
constexpr int AB_COLS = 3072, CD_COLS = 7168;
constexpr int MAXTILES = 168, NSLOT = MAXTILES * 256;
constexpr float EPS = 1e-6f;
constexpr int NWAVES = 8, NTHR = 512;
constexpr int LDS_STAGE = 131072, MISC_OFF = 145408, LDS_BYTES = 147456;
constexpr int NPH = 20;
constexpr int KSPLIT = 16;

constexpr size_t al256(size_t x) { return (x + 255) & ~(size_t)255; }
constexpr size_t WS_CTL = 0, CTL_BYTES = 65536;
constexpr size_t WS_MODP = WS_CTL + CTL_BYTES;
constexpr size_t WS_MODV = WS_MODP + al256((size_t)KSPLIT * 2 * 3 * 6 * D * 4);
constexpr size_t WS_WABIN = WS_MODV + al256((size_t)2 * 3 * 6 * D * 4);
constexpr size_t WS_WOUT = WS_WABIN + (size_t)AB_COLS * D * 2;
constexpr size_t WS_WCDIN = WS_WOUT + (size_t)2 * D * D * 2;
constexpr size_t WS_WGU = WS_WCDIN + (size_t)CD_COLS * D * 2;
constexpr size_t WS_WDN = WS_WGU + (size_t)2 * NE * 2048 * D * 2;
constexpr size_t WS_FA = WS_WDN + (size_t)2 * NE * D * DE * 2;
constexpr size_t WS_GC = WS_FA + (size_t)128 * 128 * 2;
constexpr size_t WS_DLC = WS_GC + (size_t)64 * 128 * 2;
constexpr size_t WS_F256 = WS_DLC + (size_t)256 * 512 * 2;
constexpr size_t WS_XL = WS_F256 + (size_t)512 * 256 * 2;
constexpr size_t WS_H = WS_XL + (size_t)NTOK * D * 4;
constexpr size_t WS_PA = WS_H + (size_t)NTOK * D * 2;
constexpr size_t WS_PZ = WS_PA + (size_t)NTOK * 1024 * 2;
constexpr size_t WS_ZT = WS_PZ + (size_t)NTOK * 2048 * 2;
constexpr size_t WS_ZTC = WS_ZT + (size_t)2 * 1024 * 2 * 4096 * 2;
constexpr size_t WS_MIX = WS_ZTC + (size_t)2 * 1024 * 2 * 256 * 2;
constexpr size_t WS_O = WS_MIX + (size_t)NTOK * D * 2;
constexpr size_t WS_TOKE = WS_O + (size_t)NTOK * D * 2;
constexpr size_t WS_TOKR = WS_TOKE + al256((size_t)NTOK * 4 * 4);
constexpr size_t WS_TOKP = WS_TOKR + al256((size_t)NTOK * 4 * 4);
constexpr size_t WS_LIST = WS_TOKP + al256((size_t)NTOK * 4 * 4);
constexpr size_t WS_ACT = WS_LIST + al256((size_t)NE * LCAP * 4);
constexpr size_t WS_YS = WS_ACT + (size_t)NSLOT * DE * 2;
constexpr size_t WS_H2 = WS_YS + (size_t)NSLOT * D * 2;
constexpr size_t WS_Q = WS_H2 + (size_t)NTOK * D * 2;
constexpr size_t WS_LF = WS_Q + (size_t)NTOK * 1024 * 2;
constexpr size_t WS_V = WS_LF + (size_t)NTOK * 2048 * 4;
constexpr size_t WS_G = WS_V + (size_t)NTOK * 1024 * 2;
constexpr size_t WS_LG = WS_G + (size_t)NTOK * 1024 * 2;
constexpr size_t WS_LX = WS_LG + (size_t)NTOK * 1024 * 2;
constexpr size_t WS_LA = WS_LX + (size_t)NTOK * 1024 * 2;
constexpr size_t WS_LU = WS_LA + (size_t)2 * NTOK * 1024 * 4;
constexpr size_t WS_OD = WS_LU + (size_t)2 * NTOK * 1024 * 4;
constexpr size_t WS_HS = WS_OD + (size_t)2 * NLAT * 1024 * 4;
constexpr size_t WS_ST = WS_HS + (size_t)2 * NLAT * 1024 * 4;
constexpr size_t WS_DT = WS_ST + (size_t)32 * 16 * 128 * 128 * 4;
constexpr size_t WS_ST2 = WS_DT + (size_t)32 * 16 * 128 * 4;
constexpr size_t WS_WRT = WS_ST2 + (size_t)32 * 16 * 128 * 128 * 4;
constexpr size_t WS_PS = WS_WRT + (size_t)2 * 2 * 8 * 128 * 128 * 2;
constexpr size_t WS_ES = WS_PS + (size_t)2 * 136 * 1024 * 4;
constexpr size_t WS_HI = WS_ES + (size_t)2 * 136 * 1024 * 4;
constexpr size_t WS_GST = WS_HI + (size_t)2 * 136 * 1024 * 4;
constexpr size_t WS_RWH = WS_GST + (size_t)NTOK * 2 * 4;
constexpr size_t WS_RWL = WS_RWH + (size_t)2 * 32 * 2048 * 2;
constexpr size_t WS_RGN1 = WS_RWL + (size_t)2 * 32 * 2048 * 2;
constexpr size_t WS_END = WS_RGN1 + (WS_Q - WS_H);
__host__ __device__ constexpr size_t LOFF(int layer) { return layer ? (WS_RGN1 - WS_H) : 0; }

#define XB_TMO      128
#define XB_XCNT(j)  (256  + 64 * (j))
#define XB_XSUB(j)  (1280 + 64 * (j))
#define XB_XGEN(j)  (2304 + 64 * (j))
#define XB_TOP      3328
#define XB_TOPGEN   3392
#define XCD_BAR_WORDS 3456
#define XB_SPIN_CAP (1u << 22)
constexpr int CW_BAR = 0, CW_CNT = 4096, CNT_STRIDE = 32;

__device__ __forceinline__ unsigned xb_ld(unsigned* p)              { return __hip_atomic_load(p, __ATOMIC_RELAXED, __HIP_MEMORY_SCOPE_AGENT); }
__device__ __forceinline__ unsigned xb_add(unsigned* p, unsigned v) { return __hip_atomic_fetch_add(p, v, __ATOMIC_RELAXED, __HIP_MEMORY_SCOPE_AGENT); }
__device__ __forceinline__ unsigned xb_xcc_id() { return (unsigned)__builtin_amdgcn_s_getreg((3 << 11) | 20) & 0xFu; }
#define XB_SPIN(cond, bar) do { unsigned _sp = 0; while (cond) { __builtin_amdgcn_s_sleep(1); \
    if ((++_sp & 255u) == 0u) { if (xb_ld(&(bar)[XB_TMO])) break; if (_sp > XB_SPIN_CAP) { atomicAdd(&(bar)[XB_TMO], 1u); break; } } } } while (0)
struct XcdBarrier { unsigned* bar; unsigned x; volatile LAS unsigned* st; };
__device__ __forceinline__ XcdBarrier xcd_barrier_post(unsigned* bar, volatile LAS unsigned* st) {
    XcdBarrier b; b.bar = bar; b.x = xb_xcc_id(); b.st = st;
    if (threadIdx.x == 0) (void)xb_add(&bar[XB_XCNT(b.x)], 1u);
    return b;
}
__device__ __forceinline__ void xcd_barrier_complete(unsigned* bar, unsigned x, unsigned& nloc, unsigned& nx) {
    const unsigned G = gridDim.x * gridDim.y * gridDim.z;
    unsigned sum, cnt, mine, sp = 0u;
    for (;;) {
        sum = 0u; cnt = 0u; mine = 0u;
#pragma unroll
        for (unsigned j = 0; j < 16; ++j) { const unsigned c = xb_ld(&bar[XB_XCNT(j)]); sum += c; cnt += (c > 0u) ? 1u : 0u; mine = (j == x) ? c : mine; }
        if (sum == G) break;
        __builtin_amdgcn_s_sleep(1);
        if ((++sp & 255u) == 0u) { if (xb_ld(&bar[XB_TMO])) break; if (sp > XB_SPIN_CAP) { atomicAdd(&bar[XB_TMO], 1u); break; } }
    }
    nloc = mine > 0u ? mine : 1u; nx = cnt > 0u ? cnt : 1u;
}
__device__ __forceinline__ void xcd_barrier(const XcdBarrier& b) {
    asm volatile("s_waitcnt vmcnt(0)" ::: "memory");
    __syncthreads();
    if (threadIdx.x == 0) {
        unsigned* bar = b.bar;
        __builtin_amdgcn_s_waitcnt(0);
        unsigned nloc = b.st[0], nx = b.st[1];
        if (nloc == 0u) { xcd_barrier_complete(bar, b.x, nloc, nx); b.st[0] = nloc; b.st[1] = nx; }
        const unsigned old = xb_add(&bar[XB_XSUB(b.x)], 1u);
        const unsigned gen = old / nloc;
        if (old + 1u == (gen + 1u) * nloc) {
            __builtin_amdgcn_fence(__ATOMIC_RELEASE, "agent");
            asm volatile("s_waitcnt vmcnt(0)" ::: "memory");
            const unsigned og = xb_add(&bar[XB_TOP], 1u);
            const unsigned tg = og / nx;
            if (og + 1u == (tg + 1u) * nx) xb_add(&bar[XB_TOPGEN], 1u);
            else XB_SPIN(xb_ld(&bar[XB_TOPGEN]) == tg, bar);
            __builtin_amdgcn_fence(__ATOMIC_ACQUIRE, "agent");
            xb_add(&bar[XB_XGEN(b.x)], 1u);
            asm volatile("s_waitcnt vmcnt(0)" ::: "memory");
        } else {
            XB_SPIN(xb_ld(&bar[XB_XGEN(b.x)]) == gen, bar);
            __builtin_amdgcn_fence(__ATOMIC_ACQUIRE, "agent");
            asm volatile("s_waitcnt vmcnt(0)" ::: "memory");
        }
    }
    __syncthreads();
}

typedef __bf16 bf16x2_t __attribute__((ext_vector_type(2)));
__device__ __forceinline__ unsigned pk2(float lo, float hi) { const f32x2 v = {lo, hi}; return __builtin_bit_cast(unsigned, __builtin_convertvector(v, bf16x2_t)); }
__device__ __forceinline__ float bflo(unsigned w) { return __uint_as_float(w << 16); }
__device__ __forceinline__ float bfhi(unsigned w) { return __uint_as_float(w & 0xffff0000u); }
__device__ __forceinline__ float bf1(bf16_t b) { return __uint_as_float((unsigned)b << 16); }
__device__ __forceinline__ float wave_sum(float v) {
#pragma unroll
    for (int o = 1; o < 64; o <<= 1) v += __shfl_xor(v, o);
    return v;
}
__device__ __forceinline__ float rdl(float v, int l) { return __uint_as_float((unsigned)__builtin_amdgcn_readlane((int)__float_as_uint(v), l)); }
__device__ __forceinline__ float sigmoidf_(float x) { return __builtin_amdgcn_rcpf(1.0f + __expf(-x)); }
__device__ __forceinline__ float siluf_(float x) { return x * sigmoidf_(x); }
__device__ __forceinline__ float gelu_tanh(float x) { const float y = 1.5957691216057308f * (x + 0.044715f * x * x * x); return x * sigmoidf_(y); }

namespace pg8 {
constexpr int BM = 256, BK = 64, HALF = 128, HTB = HALF * BK * 2, STAGE_BYTES = 8 * HTB;
__device__ __forceinline__ int lds_byte(int r, int c) { const int st = (r >> 4) * 2 + (c >> 5), rr = r & 15, cc = c & 31, ob = rr * 64 + cc * 2; return st * 1024 + (ob ^ (((ob >> 9) & 1) << 5)); }
__device__ __forceinline__ void stage_rc(int b, int& R, int& C) { const int st = b / 1024, sb = b % 1024, swz = sb ^ (((sb >> 9) & 1) << 5); R = (st >> 1) * 16 + swz / 64; C = (st & 1) * 32 + (swz % 64) / 2; }
__device__ __forceinline__ int perm32(int rho) { const int n = rho >> 4, i = rho & 15; return 8 * (i >> 2) + 4 * n + (i & 3); }
struct LanePos { int R[2], C[2]; };
template <bool GATHER> struct UnitAO { unsigned ao[2][2]; };
template <> struct UnitAO<false> {};
template <bool GATHER> struct Unit : UnitAO<GATHER> {
    unsigned a0, a1, b0, b1;
    int nt;
    int full;
    int p0, p1, p2;
};
template <bool GATHER> __device__ __forceinline__ unsigned unit_ao(const Unit<GATHER>& u, int h, int i, const unsigned (&voffA)[2]) { if constexpr (GATHER) return u.ao[h][i]; else return voffA[i]; }
template <class Epi, class Sched, bool GATHER>
__device__ __forceinline__ void gemm_phase(LAS unsigned char* lds, const Sched& S, const Epi& E, int tid_in) {
    int tid = tid_in; asm volatile("" : "+v"(tid));
    const int wid = __builtin_amdgcn_readfirstlane(tid >> 6), lane = tid & 63, wr = wid >> 2, wc = wid & 3, fr = lane & 15, fq = lane >> 4;
    LanePos lp; unsigned voffB[2], voffA[2];
#pragma unroll
    for (int i = 0; i < 2; ++i) { int R, C; stage_rc(tid * 16 + i * 8192, R, C); lp.R[i] = R; lp.C[i] = C; const int Rb = (R & ~31) + perm32(R & 31); voffB[i] = (unsigned)(S.brow(Rb) * S.ldb + C) * 2u; voffA[i] = (unsigned)(R * S.lda + C) * 2u; }
    const unsigned kstep = (unsigned)(BK * 2); constexpr unsigned kstepB = Sched::KSTEPB, kstepA = Sched::KSTEPA;
    const unsigned ldsw = (unsigned)wid * 1024u;
    const int aoff = lds_byte(wr * 64 + fr, fq * 8), boff = lds_byte(wc * 32 + fr, fq * 8);
    const char* const Abase = S.Abase; const char* const Bbase = S.Bbase;
#define PG8_SA(b, h) (((b) * 2 + (h)) * HTB)
#define PG8_SB(b, h) ((4 + (b) * 2 + (h)) * HTB)
#define PG8_STAGE(bufoff, gbase, o0, o1) do { \
        __builtin_amdgcn_global_load_lds((const unsigned*)((gbase) + (o0)), (LAS unsigned*)(lds + (bufoff) + ldsw), 16, 0, 0); \
        __builtin_amdgcn_global_load_lds((const unsigned*)((gbase) + (o1)), (LAS unsigned*)(lds + (bufoff) + ldsw + 8192), 16, 0, 0); } while (0)
#define PG8_STAGE_B(bufoff, uoff) PG8_STAGE(bufoff, Bbase + (size_t)(uoff), voffB[0], voffB[1])
#define PG8_STAGE_A(bufoff, uoff, o0, o1) PG8_STAGE(bufoff, Abase + (size_t)(uoff), o0, o1)
#define PG8_AO(U, h, i) unit_ao<GATHER>(U, h, i, voffA)
#define PG8_LDA(dst, b, h) do { _Pragma("unroll") for (int m = 0; m < 4; ++m) _Pragma("unroll") for (int k = 0; k < 2; ++k) dst[m][k] = *(const LAS bf16x8*)(lds + PG8_SA(b, h) + aoff + m * 2048 + k * 1024); } while (0)
#define PG8_LDB(dst, b, h) do { _Pragma("unroll") for (int n = 0; n < 2; ++n) _Pragma("unroll") for (int k = 0; k < 2; ++k) dst[n][k] = *(const LAS bf16x8*)(lds + PG8_SB(b, h) + boff + n * 2048 + k * 1024); } while (0)
#define PG8_MMA(ai, bj, At, Bt) do { __builtin_amdgcn_s_setprio(1); _Pragma("unroll") for (int m = 0; m < 4; ++m) _Pragma("unroll") for (int n = 0; n < 2; ++n) _Pragma("unroll") for (int k = 0; k < 2; ++k) \
        acc[ai][bj][m][n] = __builtin_amdgcn_mfma_f32_16x16x32_bf16(Bt[n][k], At[m][k], acc[ai][bj][m][n], 0, 0, 0); __builtin_amdgcn_s_setprio(0); } while (0)
#define PG8_WAIT_V(n) asm volatile("s_waitcnt vmcnt(" #n ")" ::: "memory")
#define PG8_WAIT_L(n) asm volatile("s_waitcnt lgkmcnt(" #n ")" ::: "memory")
#define PG8_BAR __builtin_amdgcn_s_barrier()
#define PG8_SCHED __builtin_amdgcn_sched_barrier(0)
    Unit<GATHER> cur, nxt; int ui = 0;
    if (!S.next(0, cur, lp)) return;
    f32x4 acc[2][2][4][2];
#pragma unroll
    for (int a = 0; a < 2; ++a)
#pragma unroll
        for (int b = 0; b < 2; ++b)
#pragma unroll
            for (int m = 0; m < 4; ++m)
#pragma unroll
                for (int n = 0; n < 2; ++n) acc[a][b][m][n] = (f32x4){0.f, 0.f, 0.f, 0.f};
    bf16x8 At[4][2], B0[2][2], B1[2][2];
    PG8_STAGE_B(PG8_SB(0, 0), cur.b0); PG8_STAGE_B(PG8_SB(0, 1), cur.b1); PG8_STAGE_A(PG8_SA(0, 0), cur.a0, PG8_AO(cur, 0, 0), PG8_AO(cur, 0, 1)); PG8_STAGE_A(PG8_SA(0, 1), cur.a1, PG8_AO(cur, 1, 0), PG8_AO(cur, 1, 1));
    if (wr == 1) PG8_BAR;
    PG8_WAIT_V(2); PG8_BAR;
    PG8_STAGE_B(PG8_SB(1, 0), cur.b0 + kstepB); PG8_STAGE_A(PG8_SA(1, 0), cur.a0 + kstepA, PG8_AO(cur, 0, 0), PG8_AO(cur, 0, 1)); PG8_STAGE_B(PG8_SB(1, 1), cur.b1 + kstepB);
    PG8_WAIT_V(6); PG8_BAR;
    for (;;) {
        const bool has_next = S.next(ui + 1, nxt, lp);
        if (!has_next) nxt = cur;
        const int nt = cur.nt; const bool full = cur.full != 0;
#define PG8_TRIP(FULL) do { \
              \
            PG8_LDB(B0, 0, 0); PG8_LDB(B1, 0, 1); PG8_SCHED; PG8_LDA(At, 0, 0); PG8_STAGE_A(PG8_SA(1, 1), cur.a1 + k1, PG8_AO(cur, 1, 0), PG8_AO(cur, 1, 1)); \
            PG8_WAIT_V(8); PG8_WAIT_L(0); PG8_BAR; PG8_MMA(0, 0, At, B0); PG8_MMA(0, 1, At, B1); PG8_BAR; PG8_SCHED; \
              \
            PG8_LDA(At, 0, 1); PG8_STAGE_B(PG8_SB(0, 0), b0n); PG8_STAGE_B(PG8_SB(0, 1), b1n); PG8_STAGE_A(PG8_SA(0, 0), a0n, o00, o01); \
            PG8_WAIT_V(8); PG8_WAIT_L(0); PG8_BAR; if (FULL) { PG8_MMA(1, 0, At, B0); PG8_MMA(1, 1, At, B1); } PG8_BAR; PG8_SCHED; \
              \
            PG8_LDB(B0, 1, 0); PG8_LDB(B1, 1, 1); PG8_SCHED; PG8_LDA(At, 1, 0); PG8_STAGE_A(PG8_SA(0, 1), a1n, o10, o11); \
            PG8_WAIT_V(8); PG8_WAIT_L(0); PG8_BAR; PG8_MMA(0, 0, At, B0); PG8_MMA(0, 1, At, B1); PG8_BAR; PG8_SCHED; \
              \
            PG8_LDA(At, 1, 1); PG8_STAGE_B(PG8_SB(1, 0), b0n + kstepB); PG8_STAGE_B(PG8_SB(1, 1), b1n + kstepB); PG8_STAGE_A(PG8_SA(1, 0), a0n + kstepA, o00, o01); \
            PG8_WAIT_V(8); PG8_WAIT_L(0); PG8_BAR; if (FULL) { PG8_MMA(1, 0, At, B0); PG8_MMA(1, 1, At, B1); } PG8_BAR; PG8_SCHED; } while (0)
        if (full) { for (int t = 0; t < nt; t += 2) {
            const bool last = (t == nt - 2);
            const unsigned k1 = (unsigned)(t + 1) * kstepA, k2 = (unsigned)(t + 2) * kstepA, k2b = (unsigned)(t + 2) * kstepB;
            const unsigned a0n = last ? nxt.a0 : cur.a0 + k2, a1n = last ? nxt.a1 : cur.a1 + k2, b0n = last ? nxt.b0 : cur.b0 + k2b, b1n = last ? nxt.b1 : cur.b1 + k2b;
            const unsigned o00 = last ? PG8_AO(nxt, 0, 0) : PG8_AO(cur, 0, 0), o01 = last ? PG8_AO(nxt, 0, 1) : PG8_AO(cur, 0, 1), o10 = last ? PG8_AO(nxt, 1, 0) : PG8_AO(cur, 1, 0), o11 = last ? PG8_AO(nxt, 1, 1) : PG8_AO(cur, 1, 1);
            PG8_TRIP(true); } }
        else { for (int t = 0; t < nt; t += 2) {
            const bool last = (t == nt - 2);
            const unsigned k1 = (unsigned)(t + 1) * kstepA, k2 = (unsigned)(t + 2) * kstepA, k2b = (unsigned)(t + 2) * kstepB;
            const unsigned a0n = last ? nxt.a0 : cur.a0 + k2, a1n = last ? nxt.a1 : cur.a1 + k2, b0n = last ? nxt.b0 : cur.b0 + k2b, b1n = last ? nxt.b1 : cur.b1 + k2b;
            const unsigned o00 = last ? PG8_AO(nxt, 0, 0) : PG8_AO(cur, 0, 0), o01 = last ? PG8_AO(nxt, 0, 1) : PG8_AO(cur, 0, 1), o10 = last ? PG8_AO(nxt, 1, 0) : PG8_AO(cur, 1, 0), o11 = last ? PG8_AO(nxt, 1, 1) : PG8_AO(cur, 1, 1);
            PG8_TRIP(false); } }
#undef PG8_TRIP
        if (wr == 0) PG8_BAR;
        E(acc, cur, wr, wc, fr, fq);
        if (!has_next) break;
#pragma unroll
        for (int a = 0; a < 2; ++a)
#pragma unroll
            for (int b = 0; b < 2; ++b)
#pragma unroll
                for (int m = 0; m < 4; ++m)
#pragma unroll
                    for (int n = 0; n < 2; ++n) acc[a][b][m][n] = (f32x4){0.f, 0.f, 0.f, 0.f};
        cur = nxt; ++ui;
        if (wr == 1) PG8_BAR;
    }
    PG8_WAIT_V(0);
    PG8_BAR;
#undef PG8_SA
#undef PG8_SB
#undef PG8_STAGE
#undef PG8_STAGE_A
#undef PG8_STAGE_B
#undef PG8_AO
#undef PG8_LDA
#undef PG8_LDB
#undef PG8_MMA
#undef PG8_WAIT_V
#undef PG8_WAIT_L
#undef PG8_BAR
#undef PG8_SCHED
}

__device__ __forceinline__ bool static_tile(int i, int G, int c, int nM, int nN, int& pm, int& pn) {
    const int nwg = nM * nN; const long L = (long)i * G + c; if (L >= nwg) return false;
    int wgid = (int)L; { const int q = nwg / 8, r = nwg % 8, xcd = wgid % 8, off = wgid / 8; wgid = (xcd < r ? xcd * (q + 1) : r * (q + 1) + (xcd - r) * q) + off; }
    const int nig = 8 * nN, gid = wgid / nig, fm = gid * 8, gsz = (nM - fm) < 8 ? (nM - fm) : 8;
    pm = fm + ((wgid % nig) % gsz); pn = (wgid % nig) / gsz; return true;
}
struct SchedPlain {
    static constexpr unsigned KSTEPA = 128u;
    static constexpr unsigned KSTEPB = 128u;
    const char* Abase; const char* Bbase; int lda, ldb, nM, nN, K, G, c;
    __device__ __forceinline__ int brow(int r) const { return r; }
    __device__ __forceinline__ bool next(int i, Unit<false>& u, const LanePos& lp) const {
        int pm, pn; if (!static_tile(i, G, c, nM, nN, pm, pn)) return false;
        u.a0 = (unsigned)(pm * 256 * lda) * 2u; u.a1 = u.a0 + (unsigned)(128 * lda) * 2u;
        u.b0 = (unsigned)(pn * 256 * ldb) * 2u; u.b1 = u.b0 + (unsigned)(128 * ldb) * 2u;
        u.nt = K / BK; u.full = 1; u.p0 = pm; u.p1 = pn; u.p2 = 0; return true;
    }
};
}
using pg8::Unit;

#define EPI_LOOP_ROWS for (int ai = 0; ai < 2; ++ai) _Pragma("unroll") for (int m = 0; m < 4; ++m)
struct EpiRaw {
    bf16_t* O; int ldc;
    __device__ __forceinline__ void operator()(const f32x4 (&acc)[2][2][4][2], const Unit<false>& u, int wr, int wc, int fr, int fq) const {
        const int row0 = u.p0 * 256 + wr * 64 + fr, col0 = u.p1 * 256 + wc * 32 + 8 * fq;
#pragma unroll
        EPI_LOOP_ROWS { bf16_t* rowp = O + (size_t)(row0 + ai * 128 + m * 16) * ldc + col0;
#pragma unroll
            for (int bj = 0; bj < 2; ++bj) { const f32x4 v0 = acc[ai][bj][m][0], v1 = acc[ai][bj][m][1];
                u32x4 w; w.x = pk2(v0[0], v0[1]); w.y = pk2(v0[2], v0[3]); w.z = pk2(v1[0], v1[1]); w.w = pk2(v1[2], v1[3]); *(u32x4*)(rowp + bj * 128) = w; } }
    }
};
struct EpiAbIn {
    bf16_t* PA; bf16_t* PZ;
    __device__ __forceinline__ void operator()(const f32x4 (&acc)[2][2][4][2], const Unit<false>& u, int wr, int wc, int fr, int fq) const {
        const int row0 = u.p0 * 256 + wr * 64 + fr; const bool isz = u.p1 >= 4;
        bf16_t* base = isz ? PZ : PA; const int ldc = isz ? 2048 : 1024; const int col0 = (isz ? (u.p1 - 4) : u.p1) * 256 + wc * 32 + 8 * fq;
#pragma unroll
        EPI_LOOP_ROWS { bf16_t* rowp = base + (size_t)(row0 + ai * 128 + m * 16) * ldc + col0;
#pragma unroll
            for (int bj = 0; bj < 2; ++bj) { f32x4 v0 = acc[ai][bj][m][0], v1 = acc[ai][bj][m][1];
                if (isz) {
#pragma unroll
                    for (int j = 0; j < 4; ++j) { v0[j] = gelu_tanh(v0[j]); v1[j] = gelu_tanh(v1[j]); } }
                u32x4 w; w.x = pk2(v0[0], v0[1]); w.y = pk2(v0[2], v0[3]); w.z = pk2(v1[0], v1[1]); w.w = pk2(v1[2], v1[3]); *(u32x4*)(rowp + bj * 128) = w; } }
    }
};
struct EpiChan {
    bf16_t* ZT;
    __device__ __forceinline__ void operator()(const f32x4 (&acc)[2][2][4][2], const Unit<false>& u, int wr, int wc, int fr, int fq) const {
        const int ri = u.p0, tt = u.p1, g = u.p2, b = tt >> 4, tq = tt & 15;
#pragma unroll
        EPI_LOOP_ROWS { const int j = ai * 128 + wr * 64 + m * 16 + fr;
#pragma unroll
            for (int bj = 0; bj < 2; ++bj) { const int col0 = bj * 128 + wc * 32 + 8 * fq, l2 = 4 * tq + (col0 >> 6), l1 = col0 & 63; const f32x4 v0 = acc[ai][bj][m][0], v1 = acc[ai][bj][m][1];
                u32x4 w; w.x = pk2(v0[0], v0[1]); w.y = pk2(v0[2], v0[3]); w.z = pk2(v1[0], v1[1]); w.w = pk2(v1[2], v1[3]);
                *(u32x4*)(ZT + ((((size_t)(b * 1024 + g * 256 + j) * 64 + l2) * 2 + ri) * 64 + l1)) = w; } }
    }
};
struct EpiChanC {
    bf16_t* ZTC;
    __device__ __forceinline__ void operator()(const f32x4 (&acc)[2][2][4][2], const Unit<false>& u, int wr, int wc, int fr, int fq) const {
        const int ri = u.p0, b = u.p1, g = u.p2, l0 = wc * 32 + 8 * fq;
#pragma unroll
        EPI_LOOP_ROWS { const int j = ai * 128 + wr * 64 + m * 16 + fr;
            bf16_t* rowp = ZTC + ((size_t)((b * 1024 + g * 256 + j) * 2 + ri)) * 256 + l0;
#pragma unroll
            for (int bj = 0; bj < 2; ++bj) { const f32x4 v0 = acc[ai][bj][m][0], v1 = acc[ai][bj][m][1];
                u32x4 w; w.x = pk2(v0[0], v0[1]); w.y = pk2(v0[2], v0[3]); w.z = pk2(v1[0], v1[1]); w.w = pk2(v1[2], v1[3]); *(u32x4*)(rowp + bj * 128) = w; } }
    }
};
struct EpiPos {
    bf16_t* MIX;
    __device__ __forceinline__ void operator()(const f32x4 (&acc)[2][2][4][2], const Unit<false>& u, int wr, int wc, int fr, int fq) const {
        const int row0 = u.p0 + wr * 64 + fr, col0 = u.p1 * 256 + wc * 32 + 8 * fq;
#pragma unroll
        EPI_LOOP_ROWS { bf16_t* rowp = MIX + (size_t)(row0 + ai * 128 + m * 16) * D + col0;
#pragma unroll
            for (int bj = 0; bj < 2; ++bj) { const f32x4 v0 = acc[ai][bj][m][0], v1 = acc[ai][bj][m][1];
                u32x4 w; w.x = pk2(v0[0], v0[1]); w.y = pk2(v0[2], v0[3]); w.z = pk2(v1[0], v1[1]); w.w = pk2(v1[2], v1[3]); *(u32x4*)(rowp + bj * 128) = w; } }
    }
};
struct EpiGU {
    bf16_t* ACT; const float* bgu;
    __device__ __forceinline__ void operator()(const f32x4 (&acc)[2][2][4][2], const Unit<true>& u, int wr, int wc, int fr, int fq) const {
        const int row0 = u.p0 + wr * 64 + fr, c0 = u.p1 * 128 + wc * 32 + 8 * fq;
        const float* bg = bgu + (size_t)u.p2 * 2048 + c0; const float* bu = bg + 1024;
        const f32x4 g0 = *(const f32x4*)bg, g1 = *(const f32x4*)(bg + 4), u0 = *(const f32x4*)bu, u1 = *(const f32x4*)(bu + 4);
#pragma unroll
        EPI_LOOP_ROWS { bf16_t* rowp = ACT + ((size_t)(((u.p0 >> 8) * 2 + ai) * 16 + u.p1 * 2 + (wc >> 1)) * 128 + wr * 64 + m * 16 + fr) * 64 + (wc & 1) * 32 + 8 * fq;
            float o[8];
#pragma unroll
            for (int j = 0; j < 4; ++j) {
                { const float gt = fminf(acc[ai][0][m][0][j] + g0[j], 7.0f); const float up = fminf(fmaxf(acc[ai][1][m][0][j] + u0[j], -7.0f), 7.0f); o[j] = gt * sigmoidf_(1.702f * gt) * (up + 1.0f); }
                { const float gt = fminf(acc[ai][0][m][1][j] + g1[j], 7.0f); const float up = fminf(fmaxf(acc[ai][1][m][1][j] + u1[j], -7.0f), 7.0f); o[4 + j] = gt * sigmoidf_(1.702f * gt) * (up + 1.0f); } }
            u32x4 w; w.x = pk2(o[0], o[1]); w.y = pk2(o[2], o[3]); w.z = pk2(o[4], o[5]); w.w = pk2(o[6], o[7]); __builtin_nontemporal_store(w, (u32x4*)rowp); }
    }
};
struct EpiDown {
    bf16_t* YS; const float* bdn;
    __device__ __forceinline__ void operator()(const f32x4 (&acc)[2][2][4][2], const Unit<false>& u, int wr, int wc, int fr, int fq) const {
        const int row0 = u.p0 + wr * 64 + fr, col0 = u.p1 * 256 + wc * 32 + 8 * fq;
        const float* bp = bdn + (size_t)u.p2 * 2048 + col0;
        f32x4 bv[2][2];
#pragma unroll
        for (int bj = 0; bj < 2; ++bj) { bv[bj][0] = *(const f32x4*)(bp + bj * 128); bv[bj][1] = *(const f32x4*)(bp + bj * 128 + 4); }
#pragma unroll
        EPI_LOOP_ROWS { bf16_t* rowp = YS + (size_t)(row0 + ai * 128 + m * 16) * D + col0;
#pragma unroll
            for (int bj = 0; bj < 2; ++bj) { const f32x4 v0 = acc[ai][bj][m][0] + bv[bj][0], v1 = acc[ai][bj][m][1] + bv[bj][1];
                u32x4 w; w.x = pk2(v0[0], v0[1]); w.y = pk2(v0[2], v0[3]); w.z = pk2(v1[0], v1[1]); w.w = pk2(v1[2], v1[3]); __builtin_nontemporal_store(w, (u32x4*)(rowp + bj * 128)); } }
    }
};
struct EpiCdIn {
    bf16_t *Q, *V, *G, *LG, *LX; float* LF; const float* lbraw;
    __device__ __forceinline__ void operator()(const f32x4 (&acc)[2][2][4][2], const Unit<false>& u, int wr, int wc, int fr, int fq) const {
        const int row0 = u.p0 * 256 + wr * 64 + fr, pn = u.p1;
        if (pn >= 4 && pn < 12) {
            const int col0 = (pn - 4) * 256 + wc * 32 + 8 * fq;
            float lb[2][8];
#pragma unroll
            for (int bj = 0; bj < 2; ++bj)
#pragma unroll
                for (int j = 0; j < 8; ++j) { const int kc = (col0 + bj * 128 + j) & 1023; lb[bj][j] = sigmoidf_(lbraw[1024 + kc] - lbraw[kc]); }
#pragma unroll
            EPI_LOOP_ROWS { float* rowp = LF + (size_t)(row0 + ai * 128 + m * 16) * 2048 + col0;
#pragma unroll
                for (int bj = 0; bj < 2; ++bj) { f32x4 o0, o1;
#pragma unroll
                    for (int j = 0; j < 4; ++j) { o0[j] = __logf(lb[bj][j] + (1.0f - lb[bj][j]) * sigmoidf_(acc[ai][bj][m][0][j])); o1[j] = __logf(lb[bj][4 + j] + (1.0f - lb[bj][4 + j]) * sigmoidf_(acc[ai][bj][m][1][j])); }
                    *(f32x4*)(rowp + bj * 128) = o0; *(f32x4*)(rowp + bj * 128 + 4) = o1; } }
            return;
        }
        int act, tl; bf16_t* base;
        if (pn < 4) { base = Q; act = 1; tl = pn; } else if (pn < 16) { base = V; act = 0; tl = pn - 12; } else if (pn < 20) { base = G; act = 1; tl = pn - 16; }
        else if (pn < 24) { base = LG; act = 2; tl = pn - 20; } else { base = LX; act = 0; tl = pn - 24; }
        const int col0 = tl * 256 + wc * 32 + 8 * fq;
#pragma unroll
        EPI_LOOP_ROWS { bf16_t* rowp = base + (size_t)(row0 + ai * 128 + m * 16) * 1024 + col0;
#pragma unroll
            for (int bj = 0; bj < 2; ++bj) { f32x4 v0 = acc[ai][bj][m][0], v1 = acc[ai][bj][m][1];
                if (act == 1) {
#pragma unroll
                    for (int j = 0; j < 4; ++j) { v0[j] = siluf_(v0[j]); v1[j] = siluf_(v1[j]); } }
                if (act == 2) {
#pragma unroll
                    for (int j = 0; j < 4; ++j) { v0[j] = gelu_tanh(v0[j]); v1[j] = gelu_tanh(v1[j]); } }
                u32x4 w; w.x = pk2(v0[0], v0[1]); w.y = pk2(v0[2], v0[3]); w.z = pk2(v1[0], v1[1]); w.w = pk2(v1[2], v1[3]); *(u32x4*)(rowp + bj * 128) = w; } }
    }
};

struct SchedChan {
    static constexpr unsigned KSTEPA = 128u;
    static constexpr unsigned KSTEPB = 128u;
    const char* Abase; const char* Bbase; int lda, ldb, G, c;
    __device__ __forceinline__ int brow(int r) const { return 64 * (r & 63) + (r >> 6); }
    __device__ __forceinline__ bool next(int i, Unit<false>& u, const pg8::LanePos& lp) const {
        const int L = i * G + c; if (L >= 4 * 2 * 32) return false;
        const int tt = L & 31, ri = (L >> 5) & 1, g = L >> 6, b = tt >> 4, tq = tt & 15;
        u.a0 = (unsigned)(ri * 256 * 256) * 2u; u.a1 = u.a0 + (unsigned)(128 * 256) * 2u;
        u.b0 = (unsigned)((b * 4096 + 4 * tq) * 1024 + g * 256) * 2u; u.b1 = u.b0 + (unsigned)(2 * 1024) * 2u;
        u.nt = 4; u.full = 1; u.p0 = ri; u.p1 = tt; u.p2 = g; return true;
    }
};
struct SchedChanC {
    static constexpr unsigned KSTEPA = 128u;
    static constexpr unsigned KSTEPB = 128u;
    const char* Abase; const char* Bbase; int lda, ldb, G, c;
    __device__ __forceinline__ int brow(int r) const { return r; }
    __device__ __forceinline__ bool next(int i, Unit<false>& u, const pg8::LanePos& lp) const {
        const int L = i * G + c; if (L >= 4 * 2 * 2) return false;
        const int b = L & 1, ri = (L >> 1) & 1, g = L >> 2;
        u.a0 = (unsigned)(ri * 256 * 256) * 2u; u.a1 = u.a0 + (unsigned)(128 * 256) * 2u;
        u.b0 = (unsigned)((NLAT + b * 256) * 1024 + g * 256) * 2u; u.b1 = u.b0 + (unsigned)(128 * 1024) * 2u;
        u.nt = 4; u.full = 1; u.p0 = ri; u.p1 = b; u.p2 = g; return true;
    }
};
struct SchedPosC {
    static constexpr unsigned KSTEPA = 128u;
    static constexpr unsigned KSTEPB = 128u;
    const char* Abase; const char* Bbase; int lda, ldb, G, c;
    __device__ __forceinline__ int brow(int r) const { return r; }
    __device__ __forceinline__ bool next(int i, Unit<false>& u, const pg8::LanePos& lp) const {
        const int L = i * G + c; if (L >= 8) return false;
        const int b = L >> 2, pn = L & 3;
        u.a0 = 0u; u.a1 = 128u * 512u * 2u;
        u.b0 = (unsigned)(b * 1024 + pn * 256) * 512u * 2u; u.b1 = u.b0 + 128u * 512u * 2u;
        u.nt = 8; u.full = 1; u.p0 = NLAT + b * 256; u.p1 = pn; u.p2 = 0; return true;
    }
};
struct SchedGU {
    static constexpr unsigned KSTEPA = 128u;
    static constexpr unsigned KSTEPB = 16384u;
    const char* Abase; const char* Bbase; const int* list; const LAS int* tpre; const LAS int* tcnt; int lda, ldb, G, c;
    __device__ __forceinline__ int brow(int r) const { return r; }
    __device__ __forceinline__ bool next(int i, Unit<true>& u, const pg8::LanePos& lp) const {
        const int ntile = tpre[32]; int ti, pn;
        if ((G & 255) == 0) { const int x = c & 7, y = (c >> 3) & 31, blk = c >> 8; ti = 32 * (i * (G >> 8) + blk) + 8 * (x >> 1) + (y >> 2); pn = 4 * (x & 1) + (y & 3); }
        else { const int L = i * G + c; ti = L >> 3; pn = L & 7; }
        if (ti >= ntile) return false;
        int e = 0;
        for (int q = 1; q < 32; ++q) e += (tpre[q] <= ti) ? 1 : 0;
        const int mt = ti - tpre[e], cnt = tcnt[e];
        u.a0 = 0u; u.a1 = 0u;
#pragma unroll
        for (int h = 0; h < 2; ++h)
#pragma unroll
            for (int p = 0; p < 2; ++p) { int rk = mt * 256 + h * 128 + lp.R[p]; rk = rk < cnt ? rk : cnt - 1; const int tok = list[e * LCAP + rk]; u.ao[h][p] = (unsigned)(tok * D + lp.C[p]) * 2u; }
        u.b0 = (unsigned)(e * 2048 * D + pn * (D / 64) * 8192) * 2u; u.b1 = u.b0 + (unsigned)(8 * (D / 64) * 8192) * 2u;
        u.nt = D / 64; u.full = (cnt - mt * 256 > 128) ? 1 : 0; u.p0 = ti * 256; u.p1 = pn; u.p2 = e; return true;
    }
};
struct SchedDown {
    static constexpr unsigned KSTEPA = 16384u;
    static constexpr unsigned KSTEPB = 16384u;
    const char* Abase; const char* Bbase; const LAS int* tpre; const LAS int* tcnt; int lda, ldb, G, c;
    __device__ __forceinline__ int brow(int r) const { return r; }
    __device__ __forceinline__ bool next(int i, Unit<false>& u, const pg8::LanePos& lp) const {
        const int ntile = tpre[32]; int ti, pn;
        if ((G & 255) == 0) { const int x = c & 7, y = (c >> 3) & 31, blk = c >> 8; ti = 32 * (i * (G >> 8) + blk) + 8 * (x >> 1) + (y >> 2); pn = 4 * (x & 1) + (y & 3); }
        else { const int L = i * G + c; ti = L >> 3; pn = L & 7; }
        if (ti >= ntile) return false;
        int e = 0;
        for (int q = 1; q < 32; ++q) e += (tpre[q] <= ti) ? 1 : 0;
        u.a0 = (unsigned)(ti * 256 * DE) * 2u; u.a1 = u.a0 + (unsigned)(128 * DE) * 2u;
        u.b0 = (unsigned)(e * 2048 * DE + 2 * pn * (DE / 64) * 8192) * 2u; u.b1 = u.b0 + (unsigned)((DE / 64) * 8192) * 2u;
        u.nt = DE / 64; u.full = (tcnt[e] - (ti - tpre[e]) * 256 > 128) ? 1 : 0; u.p0 = ti * 256; u.p1 = pn; u.p2 = e; return true;
    }
};

struct Args { const float* in[29]; float* out; unsigned char* ws; int ph_lo, ph_hi; };
typedef const __attribute__((address_space(4))) Args* KA;
__device__ __forceinline__ KA get_args() { KA p = (KA)__builtin_amdgcn_kernarg_segment_ptr(); asm volatile("" : "+s"(p)); return p; }
enum { I_X = 0, I_C, I_CTX, I_CCTX, I_MODW, I_MODB, I_NORMG, I_ABIN, I_ABOUT, I_VG, I_WS, I_BS, I_CDIN, I_CDOUT, I_LB, I_ONORM, I_CONVW, I_CONVB, I_WR, I_BR, I_WI, I_BI, I_LAM,
       I_RW, I_RB, I_WGU, I_BGU, I_WDN, I_BDN };

struct TrItem { const float* src; bf16_t* dst; int dj, N, db; };
template <bool GROUP8 = true, bool TILED = false>
__device__ __forceinline__ void tr_set(TrItem& t, const float* W, int K, int N, bf16_t* WT, int item, int lane) {
    const int nblk = N >> 5, nb = GROUP8 ? ((item >> 3) % (nblk >> 3)) * 8 + (item & 7) : item % nblk, kb = GROUP8 ? (item >> 3) / (nblk >> 3) : item / nblk, k0 = kb * 128, n0 = nb * 32, nq = lane & 7, ko = lane >> 3;
    t.src = W + (size_t)(k0 + 8 * ko) * N + n0 + 4 * nq; t.N = N;
    if (TILED) { t.dst = WT + ((size_t)((n0 >> 7) * (K >> 6) + 2 * kb) * 128 + (n0 & 127) + 4 * nq) * 64 + 8 * ko; t.dj = 64; t.db = 8192; }
    else { t.dst = WT + (size_t)(n0 + 4 * nq) * K + k0 + 8 * ko; t.dj = K; t.db = 64; }
}
__device__ __forceinline__ void tr_load(const TrItem& t, f32x4 (&v)[16]) {
#pragma unroll
    for (int i = 0; i < 16; ++i) v[i] = __builtin_nontemporal_load((const f32x4*)(t.src + (size_t)((i & 7) + 64 * (i >> 3)) * t.N));
}
__device__ __forceinline__ void tr_store(const TrItem& t, const f32x4 (&v)[16]) {
#pragma unroll
    for (int j = 0; j < 4; ++j) {
        u32x4 a, b;
        a.x = pk2(v[0][j], v[1][j]); a.y = pk2(v[2][j], v[3][j]); a.z = pk2(v[4][j], v[5][j]); a.w = pk2(v[6][j], v[7][j]);
        b.x = pk2(v[8][j], v[9][j]); b.y = pk2(v[10][j], v[11][j]); b.z = pk2(v[12][j], v[13][j]); b.w = pk2(v[14][j], v[15][j]);
        *(u32x4*)(t.dst + (size_t)j * t.dj) = a; *(u32x4*)(t.dst + (size_t)j * t.dj + t.db) = b;
    }
}
__device__ __forceinline__ void transpose_item(const float* __restrict__ W, int K, int N, bf16_t* __restrict__ WT, int item, int lane) {
    TrItem t; tr_set<false>(t, W, K, N, WT, item, lane); f32x4 v[16]; tr_load(t, v); tr_store(t, v);
}
constexpr int TR_A = (D / 64) * (AB_COLS / 64), TR_O = (D / 64) * (D / 64), TR_CD = (D / 64) * (CD_COLS / 64), TR_GU1 = (D / 64) * (2048 / 64), TR_DN1 = (DE / 64) * (D / 64);
constexpr int TR_NIT = TR_A + 2 * TR_O + TR_CD + 64 * TR_GU1 + 64 * TR_DN1;
__device__ __forceinline__ void tr_decode(KA a, unsigned char* ws, int it, int lane, TrItem& t) {
    int r = it;
    if (r < TR_A) { tr_set(t, a->in[I_ABIN], D, AB_COLS, (bf16_t*)(ws + WS_WABIN), r, lane); return; } r -= TR_A;
    if (r < TR_O) { tr_set(t, a->in[I_ABOUT], D, D, (bf16_t*)(ws + WS_WOUT), r, lane); return; } r -= TR_O;
    if (r < TR_O) { tr_set(t, a->in[I_CDOUT], D, D, (bf16_t*)(ws + WS_WOUT) + (size_t)D * D, r, lane); return; } r -= TR_O;
    if (r < TR_CD) { tr_set(t, a->in[I_CDIN], D, CD_COLS, (bf16_t*)(ws + WS_WCDIN), r, lane); return; } r -= TR_CD;
    { const int layer = r >= 32 * (TR_GU1 + TR_DN1) ? 1 : 0; r -= layer * 32 * (TR_GU1 + TR_DN1);
      if (r < 32 * TR_GU1) { const int m = layer * 32 + r / TR_GU1; tr_set<true, true>(t, a->in[I_WGU] + (size_t)m * D * 2048, D, 2048, (bf16_t*)(ws + WS_WGU) + (size_t)m * 2048 * D, r % TR_GU1, lane); return; } r -= 32 * TR_GU1;
      { const int m = layer * 32 + r / TR_DN1; tr_set<true, true>(t, a->in[I_WDN] + (size_t)m * DE * D, DE, D, (bf16_t*)(ws + WS_WDN) + (size_t)m * D * DE, r % TR_DN1, lane); } }
}
constexpr int FILL6_PERW = 6, FILL6_B0 = 16;
constexpr int FILL3_PERW = 6, FILL3_B0 = 152;
constexpr int FILL11_PERW = 6, FILL11_B0 = 184;
constexpr int TR_F6 = (256 - FILL6_B0) * 8 * FILL6_PERW, TR_F3 = (256 - FILL3_B0) * 8 * FILL3_PERW, TR_F11 = (256 - FILL11_B0) * 8 * FILL11_PERW, TR_FILL = TR_F6 + TR_F3 + TR_F11;
__device__ __forceinline__ void tr_run(KA a, unsigned char* ws, int it0, int it_end, int stride, int lane) {
    int it = it0;
    if (it < it_end) {
        TrItem tA, tB; f32x4 va[16], vb[16];
        tr_decode(a, ws, it, lane, tA); tr_load(tA, va);
        for (;;) {
            int nx = it + stride; bool hn = nx < it_end;
            if (hn) { tr_decode(a, ws, nx, lane, tB); tr_load(tB, vb); }
            tr_store(tA, va); if (!hn) break; it = nx;
            nx = it + stride; hn = nx < it_end;
            if (hn) { tr_decode(a, ws, nx, lane, tA); tr_load(tA, va); }
            tr_store(tB, vb); if (!hn) break; it = nx;
        }
    }
}
__device__ __forceinline__ void phase_prologue(KA a, int gw, int ngw, int lane) {
    unsigned char* ws = a->ws;
    for (int t = gw; t < 2 * 48 * KSPLIT; t += ngw) {
        const int kc = t % KSPLIT, slab = (t / KSPLIT) % 48, layer = t / (KSPLIT * 48);
        const int n0 = slab * 256 + lane * 4, k0 = kc * (D / KSPLIT);
        const float* w = a->in[I_MODW] + ((size_t)layer * D + k0) * (6 * D) + n0;
        const float cA0 = siluf_(a->in[I_C][k0 + lane]), cA1 = siluf_(a->in[I_C][D + k0 + lane]), cA2 = siluf_(a->in[I_CCTX][k0 + lane]);
        const float cB0 = siluf_(a->in[I_C][k0 + 64 + lane]), cB1 = siluf_(a->in[I_C][D + k0 + 64 + lane]), cB2 = siluf_(a->in[I_CCTX][k0 + 64 + lane]);
        f32x4 acc0 = {0.f, 0.f, 0.f, 0.f}, acc1 = acc0, acc2 = acc0;
#pragma unroll 16
        for (int k = 0; k < 64; ++k) {
            const f32x4 wv = __builtin_nontemporal_load((const f32x4*)(w + (size_t)k * (6 * D)));
            const float c0 = rdl(cA0, k), c1 = rdl(cA1, k), c2 = rdl(cA2, k);
            acc0 += wv * c0; acc1 += wv * c1; acc2 += wv * c2;
        }
#pragma unroll 16
        for (int k = 0; k < 64; ++k) {
            const f32x4 wv = __builtin_nontemporal_load((const f32x4*)(w + (size_t)(64 + k) * (6 * D)));
            const float c0 = rdl(cB0, k), c1 = rdl(cB1, k), c2 = rdl(cB2, k);
            acc0 += wv * c0; acc1 += wv * c1; acc2 += wv * c2;
        }
        float* mp = (float*)(ws + WS_MODP) + ((size_t)(kc * 2 + layer) * 3) * (6 * D) + n0;
        *(f32x4*)mp = acc0; *(f32x4*)(mp + 6 * D) = acc1; *(f32x4*)(mp + 12 * D) = acc2;
    }
    if (ngw == 2048) tr_run(a, ws, gw, TR_NIT - TR_FILL, ngw, lane); else tr_run(a, ws, gw, TR_NIT, ngw, lane);
    for (int it = gw; it < 2 * 32 * 4; it += ngw) { const int layer = it >> 7, e = (it >> 2) & 31, d0 = (it & 3) * 512 + lane * 8; const float* rwp = a->in[I_RW] + ((size_t)layer * D + d0) * NE + e;
        float hi[8], lo[8];
#pragma unroll
        for (int j = 0; j < 8; ++j) { const float w = rwp[(size_t)j * NE]; hi[j] = bflo(pk2(w, 0.f)); lo[j] = w - hi[j]; }
        u32x4 wh, wl; wh.x = pk2(hi[0], hi[1]); wh.y = pk2(hi[2], hi[3]); wh.z = pk2(hi[4], hi[5]); wh.w = pk2(hi[6], hi[7]); wl.x = pk2(lo[0], lo[1]); wl.y = pk2(lo[2], lo[3]); wl.z = pk2(lo[4], lo[5]); wl.w = pk2(lo[6], lo[7]);
        *(u32x4*)((bf16_t*)(ws + WS_RWH) + ((size_t)layer * 32 + e) * D + d0) = wh; *(u32x4*)((bf16_t*)(ws + WS_RWL) + ((size_t)layer * 32 + e) * D + d0) = wl; }
    for (int it = gw; it < 2 * 2 * 8 * 4; it += ngw) { const int m = it >> 2, dir = m >> 4, mat = (m >> 3) & 1, hh = m & 7;
        transpose_item(a->in[mat == 0 ? I_WR : I_WI] + (size_t)(dir * 8 + hh) * 128 * 128, 128, 128, (bf16_t*)(ws + WS_WRT) + (size_t)((dir * 2 + mat) * 8 + hh) * 128 * 128, it & 3, lane); }
    for (int it = gw; it < 128 + 64; it += ngw) {
        const int c0 = lane * 2; float v[2];
        if (it < 128) { const int rip = it >> 6, k1 = it & 63;
#pragma unroll
            for (int j = 0; j < 2; ++j) { const int col = c0 + j, ri = col >> 6, l1 = col & 63; const float fr = (float)((k1 * l1) & 63) * (1.0f / 64.0f);
                v[j] = rip == ri ? __builtin_amdgcn_cosf(fr) : (rip == 0 ? __builtin_amdgcn_sinf(fr) : -__builtin_amdgcn_sinf(fr)); }
            *(unsigned*)((bf16_t*)(ws + WS_FA) + it * 128 + c0) = pk2(v[0], v[1]);
        } else { const int k2 = it - 128;
#pragma unroll
            for (int j = 0; j < 2; ++j) { const int col = c0 + j, ri = col >> 6, l2 = col & 63; const float fr = (float)((k2 * l2) & 63) * (1.0f / 64.0f);
                v[j] = (ri == 0 ? __builtin_amdgcn_cosf(fr) : __builtin_amdgcn_sinf(fr)) * (1.0f / 1024.0f); }
            *(unsigned*)((bf16_t*)(ws + WS_GC) + k2 * 128 + c0) = pk2(v[0], v[1]);
        }
    }
    for (int it = gw; it < 256 + 256; it += ngw) {
        const int c0 = lane * 8; float v[8];
        if (it < 256) { const int k = it;
#pragma unroll
            for (int j = 0; j < 8; ++j) { const int col = c0 + j, l = col & 255; const float fr = (float)((k * l) & 255) * (1.0f / 256.0f);
                v[j] = (col < 256 ? __builtin_amdgcn_cosf(fr) : __builtin_amdgcn_sinf(fr)) * (1.0f / 256.0f); }
            u32x4 w; w.x = pk2(v[0], v[1]); w.y = pk2(v[2], v[3]); w.z = pk2(v[4], v[5]); w.w = pk2(v[6], v[7]);
            *(u32x4*)((bf16_t*)(ws + WS_DLC) + (size_t)k * 512 + c0) = w;
        } else { const int r2 = (it - 256) * 2;
            const int row = r2 + (lane >> 5), cc = (lane & 31) * 8, jj = row & 255;
#pragma unroll
            for (int j = 0; j < 8; ++j) { const float fr = (float)((jj * (cc + j)) & 255) * (1.0f / 256.0f); v[j] = row < 256 ? __builtin_amdgcn_cosf(fr) : -__builtin_amdgcn_sinf(fr); }
            u32x4 w; w.x = pk2(v[0], v[1]); w.y = pk2(v[2], v[3]); w.z = pk2(v[4], v[5]); w.w = pk2(v[6], v[7]);
            *(u32x4*)((bf16_t*)(ws + WS_F256) + (size_t)row * 256 + cc) = w;
        }
    }
}
__device__ __forceinline__ void phase_modfinal(KA a, int gt, int ngt) {
    const float* mp = (const float*)(a->ws + WS_MODP); float* mv = (float*)(a->ws + WS_MODV);
    for (int i = gt; i < 2 * 3 * 6 * D; i += ngt) {
        const int n = i % (6 * D), layer = i / (3 * 6 * D);
        float s = a->in[I_MODB][layer * 6 * D + n];
#pragma unroll
        for (int kc = 0; kc < KSPLIT; ++kc) s += mp[(size_t)kc * (2 * 3 * 6 * D) + i];
        mv[i] = s;
    }
}

struct Row32 { float v[32]; };
__device__ __forceinline__ void load_row_f32(const float* p, int lane, Row32& r) {
#pragma unroll
    for (int j = 0; j < 4; ++j) { const f32x4 a = *(const f32x4*)(p + 8 * lane + 512 * j), b = *(const f32x4*)(p + 8 * lane + 512 * j + 4);
        r.v[8 * j + 0] = a[0]; r.v[8 * j + 1] = a[1]; r.v[8 * j + 2] = a[2]; r.v[8 * j + 3] = a[3]; r.v[8 * j + 4] = b[0]; r.v[8 * j + 5] = b[1]; r.v[8 * j + 6] = b[2]; r.v[8 * j + 7] = b[3]; }
}
__device__ __forceinline__ void store_row_f32(float* p, int lane, const Row32& r) {
#pragma unroll
    for (int j = 0; j < 4; ++j) { *(f32x4*)(p + 8 * lane + 512 * j) = (f32x4){r.v[8 * j], r.v[8 * j + 1], r.v[8 * j + 2], r.v[8 * j + 3]}; *(f32x4*)(p + 8 * lane + 512 * j + 4) = (f32x4){r.v[8 * j + 4], r.v[8 * j + 5], r.v[8 * j + 6], r.v[8 * j + 7]}; }
}
__device__ __forceinline__ void load_row_bf16(const bf16_t* p, int lane, Row32& r) {
#pragma unroll
    for (int j = 0; j < 4; ++j) { const u32x4 w = *(const u32x4*)(p + 8 * lane + 512 * j);
        r.v[8 * j + 0] = bflo(w.x); r.v[8 * j + 1] = bfhi(w.x); r.v[8 * j + 2] = bflo(w.y); r.v[8 * j + 3] = bfhi(w.y); r.v[8 * j + 4] = bflo(w.z); r.v[8 * j + 5] = bfhi(w.z); r.v[8 * j + 6] = bflo(w.w); r.v[8 * j + 7] = bfhi(w.w); }
}
__device__ __forceinline__ void store_row_bf16(bf16_t* p, int lane, const Row32& r) {
#pragma unroll
    for (int j = 0; j < 4; ++j) { u32x4 w; w.x = pk2(r.v[8 * j], r.v[8 * j + 1]); w.y = pk2(r.v[8 * j + 2], r.v[8 * j + 3]); w.z = pk2(r.v[8 * j + 4], r.v[8 * j + 5]); w.w = pk2(r.v[8 * j + 6], r.v[8 * j + 7]); *(u32x4*)(p + 8 * lane + 512 * j) = w; }
}
__device__ __forceinline__ float row_rstd(const Row32& r) { float s = 0.f;
#pragma unroll
    for (int i = 0; i < 32; ++i) s += r.v[i] * r.v[i];
    return rsqrtf(wave_sum(s) * (1.0f / D) + EPS); }
__device__ __forceinline__ void norm_mod(const Row32& x, const float* g, const float* sc, const float* sh, int lane, Row32& hx) {
    const float rs = row_rstd(x); Row32 gg, s1, s0; load_row_f32(g, lane, gg); load_row_f32(sc, lane, s1); load_row_f32(sh, lane, s0);
#pragma unroll
    for (int i = 0; i < 32; ++i) hx.v[i] = x.v[i] * rs * gg.v[i] * (1.0f + s1.v[i]) + s0.v[i];
}
__device__ __forceinline__ void lds_fill(LAS float* dst, const float* src, int n, int tid) { for (int i = tid * 4; i < n; i += NTHR * 4) *(LAS f32x4*)(dst + i) = *(const f32x4*)(src + i); }
__device__ __forceinline__ void load_row_lds(const LAS float* p, int lane, Row32& r) {
#pragma unroll
    for (int j = 0; j < 4; ++j) { const f32x4 a = *(const LAS f32x4*)(p + 8 * lane + 512 * j), b = *(const LAS f32x4*)(p + 8 * lane + 512 * j + 4);
        r.v[8 * j + 0] = a[0]; r.v[8 * j + 1] = a[1]; r.v[8 * j + 2] = a[2]; r.v[8 * j + 3] = a[3]; r.v[8 * j + 4] = b[0]; r.v[8 * j + 5] = b[1]; r.v[8 * j + 6] = b[2]; r.v[8 * j + 7] = b[3]; }
}
__device__ __forceinline__ void norm_mod_l(const Row32& x, const LAS float* g, const LAS float* sc, const LAS float* sh, int lane, Row32& hx) {
    const float rs = row_rstd(x); Row32 gg, s1, s0; load_row_lds(g, lane, gg); load_row_lds(sc, lane, s1); load_row_lds(sh, lane, s0);
#pragma unroll
    for (int i = 0; i < 32; ++i) hx.v[i] = x.v[i] * rs * gg.v[i] * (1.0f + s1.v[i]) + s0.v[i];
}
__device__ __forceinline__ int mod_row(int r) { return r < NLAT ? (r >> 12) : 2; }
__device__ __forceinline__ const float* in_row(KA a, int r) { return r < NLAT ? a->in[I_X] + (size_t)r * D : a->in[I_CTX] + (size_t)(r - NLAT) * D; }

__device__ __forceinline__ void phase_h0(KA a, int gw, int ngw, int lane, int tid, LAS unsigned char* lds) {
    const float* mv = (const float*)(a->ws + WS_MODV); bf16_t* H = (bf16_t*)(a->ws + WS_H);
    LAS float* Lg = (LAS float*)lds; LAS float* Lm = Lg + D;
    __syncthreads();
    lds_fill(Lg, a->in[I_NORMG], D, tid);
    for (int mr = 0; mr < 3; ++mr) lds_fill(Lm + mr * 2 * D, mv + (size_t)mr * 6 * D, 2 * D, tid);
    __syncthreads();
    for (int r = gw; r < NTOK; r += ngw) {
        Row32 x, h; load_row_f32(in_row(a, r), lane, x);
        const LAS float* m = Lm + mod_row(r) * 2 * D;
        norm_mod_l(x, Lg, m + D, m, lane, h);
        store_row_bf16(H + (size_t)r * D, lane, h);
    }
    __syncthreads();
}

constexpr int RA_LD = 2056;
__device__ __forceinline__ void phase_row1(KA a, int layer, int nrows, int bid, int G, int wave, int lane, LAS unsigned char* lds) {
    unsigned char* ws = a->ws;
    const int gw = bid * NWAVES + wave, ngw = G * NWAVES, fr = lane & 15, fq = lane >> 4;
    const float* mv = (const float*)(ws + WS_MODV) + (size_t)layer * 3 * 6 * D; const float* ng = a->in[I_NORMG] + (size_t)layer * 4 * D;
    const bf16_t* O = (const bf16_t*)(ws + WS_O + LOFF(layer)); float* XL = (float*)(ws + WS_XL); bf16_t* H = (bf16_t*)(ws + WS_H2 + LOFF(layer));
    const bf16_t* WH = (const bf16_t*)(ws + WS_RWH) + (size_t)layer * 32 * D; const bf16_t* WL = (const bf16_t*)(ws + WS_RWL) + (size_t)layer * 32 * D; const float* rb = a->in[I_RB] + layer * NE;
    unsigned* cnt = (unsigned*)(ws + WS_CTL) + CW_CNT + 32 * layer * CNT_STRIDE;
    int* toke = (int*)(ws + WS_TOKE + LOFF(layer)); int* tokr = (int*)(ws + WS_TOKR + LOFF(layer)); float* tokp = (float*)(ws + WS_TOKP + LOFF(layer)); int* list = (int*)(ws + WS_LIST + LOFF(layer));
    LAS bf16_t* AH = (LAS bf16_t*)lds; LAS bf16_t* AL = (LAS bf16_t*)(lds + 16 * RA_LD * 2);
    LAS float* part = (LAS float*)lds;
    LAS float* fl = (LAS float*)(lds + 16384);
    LAS int* sel_e = (LAS int*)(lds + 131584); LAS float* sel_p = (LAS float*)(lds + 132224);
    LAS int* sel_l = (LAS int*)(lds + 132864);
    LAS int* hist = (LAS int*)(lds + 133504); LAS int* base = hist + 32;
    __syncthreads();
    if ((int)threadIdx.x < 160) sel_e[threadIdx.x] = -1;
    if ((int)threadIdx.x < 32) hist[threadIdx.x] = 0;
    for (int k0 = 0; bid * NWAVES + k0 * ngw < nrows; k0 += 2) {
        __syncthreads();
#pragma unroll
        for (int q = 0; q < 2; ++q) {
            const int r = gw + (k0 + q) * ngw; LAS bf16_t* ah = AH + (2 * wave + q) * RA_LD; LAS bf16_t* al = AL + (2 * wave + q) * RA_LD;
            if (r < nrows) {
                const float* m = mv + (size_t)mod_row(r) * 6 * D;
                Row32 o, x; load_row_bf16(O + (size_t)r * D, lane, o);
                if (layer == 0) load_row_f32(in_row(a, r), lane, x); else load_row_f32(XL + (size_t)r * D, lane, x);
                { const float rs = row_rstd(o); Row32 g1, ga; load_row_f32(ng + D, lane, g1); load_row_f32(m + 2 * D, lane, ga);
#pragma unroll
                  for (int i = 0; i < 32; ++i) x.v[i] += ga.v[i] * (o.v[i] * rs * g1.v[i]); }
                store_row_f32(XL + (size_t)r * D, lane, x);
                Row32 h; norm_mod(x, ng + 2 * D, m + 4 * D, m + 3 * D, lane, h);
#pragma unroll
                for (int j = 0; j < 4; ++j) { u32x4 wh, wl; float lo[8];
                    wh.x = pk2(h.v[8 * j], h.v[8 * j + 1]); wh.y = pk2(h.v[8 * j + 2], h.v[8 * j + 3]); wh.z = pk2(h.v[8 * j + 4], h.v[8 * j + 5]); wh.w = pk2(h.v[8 * j + 6], h.v[8 * j + 7]);
                    lo[0] = h.v[8 * j] - bflo(wh.x); lo[1] = h.v[8 * j + 1] - bfhi(wh.x); lo[2] = h.v[8 * j + 2] - bflo(wh.y); lo[3] = h.v[8 * j + 3] - bfhi(wh.y);
                    lo[4] = h.v[8 * j + 4] - bflo(wh.z); lo[5] = h.v[8 * j + 5] - bfhi(wh.z); lo[6] = h.v[8 * j + 6] - bflo(wh.w); lo[7] = h.v[8 * j + 7] - bfhi(wh.w);
                    wl.x = pk2(lo[0], lo[1]); wl.y = pk2(lo[2], lo[3]); wl.z = pk2(lo[4], lo[5]); wl.w = pk2(lo[6], lo[7]);
                    *(u32x4*)(H + (size_t)r * D + 8 * lane + 512 * j) = wh;
                    *(LAS u32x4*)(ah + 8 * lane + 512 * j) = wh; *(LAS u32x4*)(al + 8 * lane + 512 * j) = wl; }
            } else {
#pragma unroll
                for (int j = 0; j < 4; ++j) { *(LAS u32x4*)(ah + 8 * lane + 512 * j) = (u32x4){0u, 0u, 0u, 0u}; *(LAS u32x4*)(al + 8 * lane + 512 * j) = (u32x4){0u, 0u, 0u, 0u}; }
            }
        }
        __syncthreads();
        f32x4 acc[2] = {(f32x4){0.f, 0.f, 0.f, 0.f}, (f32x4){0.f, 0.f, 0.f, 0.f}};
#pragma unroll
        for (int hf = 0; hf < 2; ++hf) {
            bf16x8 bh[2][4], bl[2][4];
#pragma unroll
            for (int nt = 0; nt < 2; ++nt)
#pragma unroll
                for (int ks = 0; ks < 4; ++ks) { const size_t off = (size_t)(16 * nt + fr) * D + 256 * wave + 128 * hf + 32 * ks + 8 * fq; bh[nt][ks] = *(const bf16x8*)(WH + off); bl[nt][ks] = *(const bf16x8*)(WL + off); }
#pragma unroll
            for (int ks = 0; ks < 4; ++ks) { const int kk = 256 * wave + 128 * hf + 32 * ks + 8 * fq; const bf16x8 ah8 = *(const LAS bf16x8*)(AH + fr * RA_LD + kk), al8 = *(const LAS bf16x8*)(AL + fr * RA_LD + kk);
#pragma unroll
                for (int nt = 0; nt < 2; ++nt) { acc[nt] = __builtin_amdgcn_mfma_f32_16x16x32_bf16(ah8, bh[nt][ks], acc[nt], 0, 0, 0); acc[nt] = __builtin_amdgcn_mfma_f32_16x16x32_bf16(al8, bh[nt][ks], acc[nt], 0, 0, 0);
                    acc[nt] = __builtin_amdgcn_mfma_f32_16x16x32_bf16(ah8, bl[nt][ks], acc[nt], 0, 0, 0); } }
        }
        __syncthreads();
#pragma unroll
        for (int nt = 0; nt < 2; ++nt)
#pragma unroll
            for (int r4 = 0; r4 < 4; ++r4) part[(wave * 16 + 4 * fq + r4) * 32 + 16 * nt + fr] = acc[nt][r4];
        __syncthreads();
        { const int q = lane >> 5, e = lane & 31, row = 2 * wave + q; float s = rb[e];
#pragma unroll
          for (int w8 = 0; w8 < 8; ++w8) s += part[(w8 * 16 + row) * 32 + e];
          fl[row * 32 + e] = s; }
        asm volatile("s_waitcnt lgkmcnt(0)" ::: "memory");
        { const int q = lane >> 5, r = gw + (k0 + q) * ngw; float lg[NE];
#pragma unroll
          for (int e4 = 0; e4 < 8; ++e4) { const f32x4 v = *(const LAS f32x4*)(fl + (2 * wave + q) * 32 + 4 * e4); lg[4 * e4] = v[0]; lg[4 * e4 + 1] = v[1]; lg[4 * e4 + 2] = v[2]; lg[4 * e4 + 3] = v[3]; }
          unsigned taken = 0u; float tv[4]; int te[4];
#pragma unroll
          for (int k = 0; k < 4; ++k) { float best = -3.0e38f; int bi = 0;
#pragma unroll
              for (int e = 0; e < NE; ++e) { const bool ok = !((taken >> e) & 1u) && lg[e] > best; best = ok ? lg[e] : best; bi = ok ? e : bi; }
              taken |= 1u << bi; tv[k] = best; te[k] = bi; }
          float p[4], ps = 0.f;
#pragma unroll
          for (int k = 0; k < 4; ++k) { p[k] = __expf(tv[k] - tv[0]); ps += p[k]; }
          const float inv = 1.0f / ps; const int sl = lane & 31;
          if (sl < 4 && r < nrows) {
              const int e = sl == 0 ? te[0] : sl == 1 ? te[1] : sl == 2 ? te[2] : te[3];
              const float pp = (sl == 0 ? p[0] : sl == 1 ? p[1] : sl == 2 ? p[2] : p[3]) * inv;
              const int slot = (k0 + q) * 8 + wave; sel_e[slot * 4 + sl] = e; sel_p[slot * 4 + sl] = pp;
          } }
    }
    __syncthreads();
    const int it = threadIdx.x; int my_e = -1;
    if (it < 160) { my_e = sel_e[it]; if (my_e >= 0) sel_l[it] = __hip_atomic_fetch_add(hist + my_e, 1, __ATOMIC_RELAXED, __HIP_MEMORY_SCOPE_WORKGROUP); }
    __syncthreads();
    if (it < 32) { const int h = hist[it]; base[it] = h ? (int)__hip_atomic_fetch_add(cnt + it * CNT_STRIDE, (unsigned)h, __ATOMIC_RELAXED, __HIP_MEMORY_SCOPE_AGENT) : 0; }
    __syncthreads();
    if (it < 160 && my_e >= 0) { const int slot = it >> 2, sl = it & 3, r = bid * NWAVES + (slot & 7) + (slot >> 3) * ngw, rank = base[my_e] + sel_l[it];
        list[my_e * LCAP + rank] = r; toke[r * 4 + sl] = my_e; tokr[r * 4 + sl] = rank; tokp[r * 4 + sl] = sel_p[it]; }
}
__device__ __forceinline__ void moe_tables(KA a, int layer, LAS int* tpre, LAS int* tcnt) {
    __syncthreads();
    if (threadIdx.x < 64) {
        const unsigned* cnt = (const unsigned*)(a->ws + WS_CTL) + CW_CNT + 32 * layer * CNT_STRIDE; const int e = threadIdx.x & 31;
        const int c = (int)__hip_atomic_load(cnt + e * CNT_STRIDE, __ATOMIC_RELAXED, __HIP_MEMORY_SCOPE_AGENT), tl = (c + 255) >> 8; int inc = tl;
#pragma unroll
        for (int o = 1; o < 32; o <<= 1) { const int v = __shfl_up(inc, o, 32); if (e >= o) inc += v; }
        if (threadIdx.x < 32) { tcnt[e] = c; tpre[e] = inc - tl; if (e == 31) tpre[32] = inc; }
    }
    __syncthreads();
}
__device__ __forceinline__ void phase_combine(KA a, int layer, int nrows, int gw, int ngw, int lane, int tid, LAS unsigned char* lds, const LAS int* tpre) {
    unsigned char* ws = a->ws;
    const float* mv = (const float*)(ws + WS_MODV) + (size_t)layer * 3 * 6 * D; const float* ng = a->in[I_NORMG] + (size_t)layer * 4 * D;
    const bf16_t* YS = (const bf16_t*)(ws + WS_YS + LOFF(layer)); float* XL = (float*)(ws + WS_XL); bf16_t* H = (bf16_t*)(ws + WS_H + LOFF(1));
    const int* toke = (const int*)(ws + WS_TOKE + LOFF(layer)); const int* tokr = (const int*)(ws + WS_TOKR + LOFF(layer)); const float* tokp = (const float*)(ws + WS_TOKP + LOFF(layer));
    LAS float* Lg = (LAS float*)lds;
    LAS float* Lga = Lg + 2 * D;
    LAS float* Lm1 = Lga + 3 * D;
    __syncthreads();
    lds_fill(Lg, ng + 3 * D, layer == 0 ? 2 * D : D, tid);
    for (int mr = 0; mr < 3; ++mr) { lds_fill(Lga + mr * D, mv + (size_t)mr * 6 * D + 5 * D, D, tid); if (layer == 0) lds_fill(Lm1 + mr * 2 * D, mv + (size_t)(3 + mr) * 6 * D, 2 * D, tid); }
    __syncthreads();
    for (int r = gw; r < nrows; r += ngw) {
        const int mr = mod_row(r);
        Row32 y;
#pragma unroll
        for (int i = 0; i < 32; ++i) y.v[i] = 0.f;
#pragma unroll
        for (int k = 0; k < 4; ++k) { const int e = toke[r * 4 + k], rk = tokr[r * 4 + k]; const float p = tokp[r * 4 + k]; const int slot = tpre[e] * 256 + rk;
            Row32 t; load_row_bf16(YS + (size_t)slot * D, lane, t);
#pragma unroll
            for (int i = 0; i < 32; ++i) y.v[i] += p * t.v[i]; }
        Row32 x; load_row_f32(XL + (size_t)r * D, lane, x);
        asm volatile("" ::: "memory");
        { const float rs = row_rstd(y); Row32 g3, ga; load_row_lds(Lg, lane, g3); load_row_lds(Lga + mr * D, lane, ga);
#pragma unroll
          for (int i = 0; i < 32; ++i) x.v[i] += ga.v[i] * (y.v[i] * rs * g3.v[i]); }
        if (layer == 1) { store_row_f32(a->out + (size_t)r * D, lane, x); }
        else {
            store_row_f32(XL + (size_t)r * D, lane, x);
            asm volatile("" ::: "memory");
            const LAS float* m1 = Lm1 + mr * 2 * D;
            Row32 h; norm_mod_l(x, Lg + D, m1 + D, m1, lane, h);
            store_row_bf16(H + (size_t)r * D, lane, h);
        }
    }
    __syncthreads();
}

constexpr int XC_LD = 136;
__device__ __forceinline__ void gmlp_stats(KA a, int gw, int ngw, int lane) {
    const bf16_t* PZ = (const bf16_t*)(a->ws + WS_PZ); float* GST = (float*)(a->ws + WS_GST);
    for (int r = gw; r < NTOK; r += ngw) { const bf16_t* vp = PZ + (size_t)r * 2048 + 1024 + lane * 16;
        const u32x4 w0 = *(const u32x4*)vp, w1 = *(const u32x4*)(vp + 8); float x[16];
        x[0] = bflo(w0.x); x[1] = bfhi(w0.x); x[2] = bflo(w0.y); x[3] = bfhi(w0.y); x[4] = bflo(w0.z); x[5] = bfhi(w0.z); x[6] = bflo(w0.w); x[7] = bfhi(w0.w);
        x[8] = bflo(w1.x); x[9] = bfhi(w1.x); x[10] = bflo(w1.y); x[11] = bfhi(w1.y); x[12] = bflo(w1.z); x[13] = bfhi(w1.z); x[14] = bflo(w1.w); x[15] = bfhi(w1.w);
        float s = 0.f;
#pragma unroll
        for (int j = 0; j < 16; ++j) s += x[j];
        const float mu = wave_sum(s) * (1.0f / 1024.0f); float q2 = 0.f;
#pragma unroll
        for (int j = 0; j < 16; ++j) { const float d = x[j] - mu; q2 += d * d; }
        const float rstd = rsqrtf(wave_sum(q2) * (1.0f / 1024.0f) + EPS);
        if (lane == 0) *(f32x2*)(GST + (size_t)r * 2) = (f32x2){mu, rstd}; }
}
__device__ __forceinline__ void gmlp_unit(KA a, LAS unsigned char* lds, int chunk, int hh, int& cur_hh, int tid, int lane, int wave) {
    const bf16_t* PZ = (const bf16_t*)(a->ws + WS_PZ); bf16_t* MIX = (bf16_t*)(a->ws + WS_MIX);
    LAS bf16_t* wsb = (LAS bf16_t*)lds;
    LAS bf16_t* vnT = (LAS bf16_t*)(lds + 34816);
    LAS float* st = (LAS float*)(lds + MISC_OFF + 1024);
    const int r0 = chunk * 128, fr = lane & 15, fq = lane >> 4;
    __syncthreads();
    if (hh != cur_hh) { const float* wsrc = a->in[I_WS] + (size_t)hh * 128 * 128; cur_hh = hh;
        for (int i = tid; i < 128 * 16; i += NTHR) { const int p = i >> 4, c8 = (i & 15) * 8; const f32x4 w0 = *(const f32x4*)(wsrc + p * 128 + c8), w1 = *(const f32x4*)(wsrc + p * 128 + c8 + 4);
            u32x4 o; o.x = pk2(w0[0], w0[1]); o.y = pk2(w0[2], w0[3]); o.z = pk2(w1[0], w1[1]); o.w = pk2(w1[2], w1[3]); *(LAS u32x4*)(wsb + p * XC_LD + c8) = o; } }
    if (tid < 256) st[tid] = ((const float*)(a->ws + WS_GST))[(size_t)r0 * 2 + tid];
    __syncthreads();
    for (int i = tid; i < 64 * 16; i += NTHR) { const int q = (i & 63) * 2, d0 = (i >> 6) * 8;
        const u32x4 w0 = *(const u32x4*)(PZ + (size_t)(r0 + q) * 2048 + 1024 + hh * 128 + d0), w1 = *(const u32x4*)(PZ + (size_t)(r0 + q + 1) * 2048 + 1024 + hh * 128 + d0);
        const float mu0 = st[2 * q], rs0 = st[2 * q + 1], mu1 = st[2 * q + 2], rs1 = st[2 * q + 3]; const float* vg = a->in[I_VG] + hh * 128 + d0;
        const f32x4 g0 = *(const f32x4*)vg, g1 = *(const f32x4*)(vg + 4);
        LAS unsigned* dp = (LAS unsigned*)(vnT + d0 * XC_LD + q);
        dp[0 * (XC_LD / 2)] = pk2((bflo(w0.x) - mu0) * rs0 * g0[0], (bflo(w1.x) - mu1) * rs1 * g0[0]); dp[1 * (XC_LD / 2)] = pk2((bfhi(w0.x) - mu0) * rs0 * g0[1], (bfhi(w1.x) - mu1) * rs1 * g0[1]);
        dp[2 * (XC_LD / 2)] = pk2((bflo(w0.y) - mu0) * rs0 * g0[2], (bflo(w1.y) - mu1) * rs1 * g0[2]); dp[3 * (XC_LD / 2)] = pk2((bfhi(w0.y) - mu0) * rs0 * g0[3], (bfhi(w1.y) - mu1) * rs1 * g0[3]);
        dp[4 * (XC_LD / 2)] = pk2((bflo(w0.z) - mu0) * rs0 * g1[0], (bflo(w1.z) - mu1) * rs1 * g1[0]); dp[5 * (XC_LD / 2)] = pk2((bfhi(w0.z) - mu0) * rs0 * g1[1], (bfhi(w1.z) - mu1) * rs1 * g1[1]);
        dp[6 * (XC_LD / 2)] = pk2((bflo(w0.w) - mu0) * rs0 * g1[2], (bflo(w1.w) - mu1) * rs1 * g1[2]); dp[7 * (XC_LD / 2)] = pk2((bfhi(w0.w) - mu0) * rs0 * g1[3], (bfhi(w1.w) - mu1) * rs1 * g1[3]); }
    __syncthreads();
    const int wm = wave >> 1, wn = wave & 1;
    f32x4 acc[2][4];
#pragma unroll
    for (int m = 0; m < 2; ++m)
#pragma unroll
        for (int n = 0; n < 4; ++n) acc[m][n] = (f32x4){0.f, 0.f, 0.f, 0.f};
#pragma unroll
    for (int ks = 0; ks < 4; ++ks) { bf16x8 xf[2], yf[4];
#pragma unroll
        for (int m = 0; m < 2; ++m) xf[m] = *(const LAS bf16x8*)(wsb + (32 * wm + 16 * m + fr) * XC_LD + 32 * ks + 8 * fq);
#pragma unroll
        for (int n = 0; n < 4; ++n) yf[n] = *(const LAS bf16x8*)(vnT + (64 * wn + 16 * n + fr) * XC_LD + 32 * ks + 8 * fq);
#pragma unroll
        for (int m = 0; m < 2; ++m)
#pragma unroll
            for (int n = 0; n < 4; ++n) acc[m][n] = __builtin_amdgcn_mfma_f32_16x16x32_bf16(yf[n], xf[m], acc[m][n], 0, 0, 0); }
#pragma unroll
    for (int m = 0; m < 2; ++m) { const int p = 32 * wm + 16 * m + fr; const float bias = a->in[I_BS][hh * 128 + p];
#pragma unroll
        for (int n = 0; n < 4; ++n) { const int d0 = 64 * wn + 16 * n + 4 * fq; const u32x2 uu = *(const u32x2*)(PZ + (size_t)(r0 + p) * 2048 + hh * 128 + d0);
            u32x2 o; o.x = pk2(bflo(uu.x) * (acc[m][n][0] + bias), bfhi(uu.x) * (acc[m][n][1] + bias)); o.y = pk2(bflo(uu.y) * (acc[m][n][2] + bias), bfhi(uu.y) * (acc[m][n][3] + bias));
            *(u32x2*)(MIX + (size_t)(r0 + p) * D + 1024 + hh * 128 + d0) = o; } }
}


constexpr int WP_LD = 136;
__device__ __forceinline__ void fft_unit(KA a, LAS unsigned char* lds, int unit, int tid) {
    const int b = unit >> 7, n0 = (unit & 127) * 8;
    const int lane = tid & 63, wave = __builtin_amdgcn_readfirstlane(tid >> 6), fr = lane & 15, fq = lane >> 4, n = n0 + wave;
    const bf16_t* Z = (const bf16_t*)(a->ws + WS_ZT) + (size_t)(b * 1024 + n) * 64 * 128;
    const bf16_t* FA = (const bf16_t*)(a->ws + WS_FA); const bf16_t* GC = (const bf16_t*)(a->ws + WS_GC);
    LAS bf16_t* wp = (LAS bf16_t*)(lds + wave * (64 * WP_LD * 2));
    __syncthreads();
    bf16x8 yf[4][4];
#pragma unroll
    for (int t = 0; t < 4; ++t)
#pragma unroll
        for (int ks = 0; ks < 4; ++ks) yf[t][ks] = *(const bf16x8*)(Z + (size_t)(16 * t + fr) * 128 + 32 * ks + 8 * fq);
#pragma unroll 1
    for (int aa = 0; aa < 4; ++aa) {
        bf16x8 xr[4], xi[4];
#pragma unroll
        for (int ks = 0; ks < 4; ++ks) { xr[ks] = *(const bf16x8*)(FA + (size_t)(16 * aa + fr) * 128 + 32 * ks + 8 * fq); xi[ks] = *(const bf16x8*)(FA + (size_t)(64 + 16 * aa + fr) * 128 + 32 * ks + 8 * fq); }
#pragma unroll
        for (int t = 0; t < 4; ++t) { f32x4 cr = {0.f, 0.f, 0.f, 0.f}, ci = {0.f, 0.f, 0.f, 0.f};
#pragma unroll
            for (int ks = 0; ks < 4; ++ks) { cr = __builtin_amdgcn_mfma_f32_16x16x32_bf16(yf[t][ks], xr[ks], cr, 0, 0, 0); ci = __builtin_amdgcn_mfma_f32_16x16x32_bf16(yf[t][ks], xi[ks], ci, 0, 0, 0); }
            const int k1 = 16 * aa + fr; float wr4[4], wi4[4];
#pragma unroll
            for (int r = 0; r < 4; ++r) { const int l2 = 16 * t + 4 * fq + r; const float ang = (float)(k1 * l2) * (1.0f / 4096.0f), ct = __builtin_amdgcn_cosf(ang), st = __builtin_amdgcn_sinf(ang);
                wr4[r] = cr[r] * ct + ci[r] * st; wi4[r] = ci[r] * ct - cr[r] * st; }
            u32x2 w; w.x = pk2(wr4[0], wr4[1]); w.y = pk2(wr4[2], wr4[3]); *(LAS u32x2*)(wp + k1 * WP_LD + 16 * t + 4 * fq) = w;
            w.x = pk2(wi4[0], wi4[1]); w.y = pk2(wi4[2], wi4[3]); *(LAS u32x2*)(wp + k1 * WP_LD + 64 + 16 * t + 4 * fq) = w; }
    }
    f32x4 yo[4][4];
#pragma unroll
    for (int aa = 0; aa < 4; ++aa)
#pragma unroll
        for (int c = 0; c < 4; ++c) yo[aa][c] = (f32x4){0.f, 0.f, 0.f, 0.f};
#pragma unroll
    for (int ks = 0; ks < 4; ++ks) { bf16x8 gf[4], wf4[4];
#pragma unroll
        for (int c = 0; c < 4; ++c) gf[c] = *(const bf16x8*)(GC + (size_t)(16 * c + fr) * 128 + 32 * ks + 8 * fq);
#pragma unroll
        for (int aa = 0; aa < 4; ++aa) wf4[aa] = *(const LAS bf16x8*)(wp + (16 * aa + fr) * WP_LD + 32 * ks + 8 * fq);
#pragma unroll
        for (int aa = 0; aa < 4; ++aa)
#pragma unroll
            for (int c = 0; c < 4; ++c) yo[aa][c] = __builtin_amdgcn_mfma_f32_16x16x32_bf16(gf[c], wf4[aa], yo[aa][c], 0, 0, 0); }
    __syncthreads();
    LAS bf16_t* ys = (LAS bf16_t*)lds;
#pragma unroll
    for (int aa = 0; aa < 4; ++aa)
#pragma unroll
        for (int c = 0; c < 4; ++c)
#pragma unroll
            for (int r = 0; r < 4; ++r) { const int k = 16 * aa + fr + 64 * (16 * c + 4 * fq + r); ys[k * 8 + wave] = (bf16_t)(pk2(yo[aa][c][r], 0.f) & 0xffffu); }
    __syncthreads();
    bf16_t* MIX = (bf16_t*)(a->ws + WS_MIX);
#pragma unroll
    for (int q = 0; q < 8; ++q) { const int k = tid + q * NTHR; *(u32x4*)(MIX + (size_t)(b * 4096 + k) * D + n0) = *(const LAS u32x4*)(ys + k * 8); }
}
__device__ __forceinline__ void hgrn_rows(int b, int dir, int c, int& rbase, int& rstep) {
    rstep = dir ? -1 : 1;
    if (c == 0) rbase = NLAT + b * CTXL + (dir ? CTXL - 1 : 0); else rbase = b * SEQ + (dir ? SEQ - 1 - (c - 1) * 256 : (c - 1) * 256);
}
constexpr int VT_LD = 264, ST_LD = 136, KE_LD = 40;
__device__ __forceinline__ void hgrn_stage_vT(const bf16_t* V, LAS bf16_t* vT, int rbase, int rstep, int hh, int tid) {
#pragma unroll 2
    for (int idx = tid; idx < 16 * 128; idx += NTHR) { const int s = (idx & 127) * 2, v0 = (idx >> 7) * 8;
        const u32x4 w0 = *(const u32x4*)(V + (size_t)(rbase + rstep * s) * 1024 + hh * 128 + v0), w1 = *(const u32x4*)(V + (size_t)(rbase + rstep * (s + 1)) * 1024 + hh * 128 + v0);
        LAS unsigned* d = (LAS unsigned*)(vT + v0 * VT_LD + s);
        d[0 * (VT_LD / 2)] = (w0.x & 0xffffu) | (w1.x << 16); d[1 * (VT_LD / 2)] = (w0.x >> 16) | (w1.x & 0xffff0000u);
        d[2 * (VT_LD / 2)] = (w0.y & 0xffffu) | (w1.y << 16); d[3 * (VT_LD / 2)] = (w0.y >> 16) | (w1.y & 0xffff0000u);
        d[4 * (VT_LD / 2)] = (w0.z & 0xffffu) | (w1.z << 16); d[5 * (VT_LD / 2)] = (w0.z >> 16) | (w1.z & 0xffff0000u);
        d[6 * (VT_LD / 2)] = (w0.w & 0xffffu) | (w1.w << 16); d[7 * (VT_LD / 2)] = (w0.w >> 16) | (w1.w & 0xffff0000u); }
}
__device__ __forceinline__ void hgrn_A_unit(KA a, LAS unsigned char* lds, int unit, int tid) {
    const int c = unit & 15, chain = unit >> 4, dir = chain & 1, hh = (chain >> 1) & 7, b = chain >> 4;
    const float* LF = (const float*)(a->ws + WS_LF); const bf16_t* V = (const bf16_t*)(a->ws + WS_V);
    float* ST = (float*)(a->ws + WS_ST) + (size_t)(chain * 16 + c) * 128 * 128; float* DT = (float*)(a->ws + WS_DT) + (size_t)(chain * 16 + c) * 128;
    LAS bf16_t* vT = (LAS bf16_t*)lds; LAS bf16_t* kdT = (LAS bf16_t*)(lds + 67584); LAS float* segsum = (LAS float*)(lds + 135168);
    const int lane = tid & 63, wave = __builtin_amdgcn_readfirstlane(tid >> 6), fr = lane & 15, fq = lane >> 4;
    int rbase, rstep; hgrn_rows(b, dir, c, rbase, rstep);
    __syncthreads();
    hgrn_stage_vT(V, vT, rbase, rstep, hh, tid);
    const int kc = tid & 127, seg = tid >> 7;
    const float* lfp = LF + dir * 1024 + hh * 128 + kc;
    float lfv[64]; float ssum = 0.f;
#pragma unroll
    for (int i = 0; i < 64; ++i) { lfv[i] = lfp[(size_t)(rbase + rstep * (seg * 64 + i)) * 2048]; }
#pragma unroll
    for (int i = 0; i < 64; ++i) ssum += lfv[i];
    segsum[seg * 128 + kc] = ssum;
    __syncthreads();
    { const float s0 = segsum[kc], s1 = segsum[128 + kc], s2 = segsum[256 + kc], s3 = segsum[384 + kc];
      const float total = (s0 + s1) + (s2 + s3); float cum = (seg > 0 ? s0 : 0.f) + (seg > 1 ? s1 : 0.f) + (seg > 2 ? s2 : 0.f);
      if (seg == 0) DT[kc] = __expf(total);
#pragma unroll
      for (int i = 0; i < 64; i += 2) { cum += lfv[i]; const float kd0 = (1.0f - __expf(lfv[i])) * __expf(total - cum); cum += lfv[i + 1]; const float kd1 = (1.0f - __expf(lfv[i + 1])) * __expf(total - cum);
          *(LAS unsigned*)(kdT + kc * VT_LD + seg * 64 + i) = pk2(kd0, kd1); } }
    __syncthreads();
    const int wm = wave >> 1, wn = wave & 1;
    f32x4 acc[2][4];
#pragma unroll
    for (int m = 0; m < 2; ++m)
#pragma unroll
        for (int n = 0; n < 4; ++n) acc[m][n] = (f32x4){0.f, 0.f, 0.f, 0.f};
#pragma unroll 2
    for (int ks = 0; ks < 8; ++ks) {
        bf16x8 vf[2], kf[4];
#pragma unroll
        for (int m = 0; m < 2; ++m) vf[m] = *(const LAS bf16x8*)(vT + (32 * wm + 16 * m + fr) * VT_LD + 32 * ks + 8 * fq);
#pragma unroll
        for (int n = 0; n < 4; ++n) kf[n] = *(const LAS bf16x8*)(kdT + (64 * wn + 16 * n + fr) * VT_LD + 32 * ks + 8 * fq);
#pragma unroll
        for (int m = 0; m < 2; ++m)
#pragma unroll
            for (int n = 0; n < 4; ++n) acc[m][n] = __builtin_amdgcn_mfma_f32_16x16x32_bf16(kf[n], vf[m], acc[m][n], 0, 0, 0);
    }
#pragma unroll
    for (int m = 0; m < 2; ++m)
#pragma unroll
        for (int n = 0; n < 4; ++n) *(f32x4*)(ST + (size_t)(32 * wm + 16 * m + fr) * 128 + 64 * wn + 16 * n + 4 * fq) = acc[m][n];
}
__device__ __forceinline__ void hgrn_B(KA a, int gt, int ngt) {
    for (int idx = gt; idx < 32 * 128 * 32; idx += ngt) {
        const int chain = idx >> 12, rem = idx & 4095, vc = rem >> 5, k4 = (rem & 31) * 4;
        const float* stp = (const float*)(a->ws + WS_ST) + ((size_t)chain * 16 * 128 + vc) * 128 + k4; float* st2 = (float*)(a->ws + WS_ST2) + ((size_t)chain * 16 * 128 + vc) * 128 + k4; const float* dtp = (const float*)(a->ws + WS_DT) + (size_t)chain * 16 * 128 + k4;
        f32x4 U[16], Dv[16];
#pragma unroll
        for (int c = 0; c < 16; ++c) { U[c] = *(const f32x4*)(stp + (size_t)c * 128 * 128); Dv[c] = *(const f32x4*)(dtp + c * 128); }
        f32x4 S = {0.f, 0.f, 0.f, 0.f};
#pragma unroll
        for (int c = 0; c < 16; ++c) { S = Dv[c] * S + U[c]; *(f32x4*)(st2 + (size_t)c * 128 * 128) = S; }
    }
}
__device__ __forceinline__ void hgrn_C_unit(KA a, LAS unsigned char* lds, int unit, int tid) {
    const int cl = unit & 15, hh = (unit >> 4) & 7, b = unit >> 7, r0 = b * SEQ + cl * 256;
    const float* LF = (const float*)(a->ws + WS_LF); const bf16_t* V = (const bf16_t*)(a->ws + WS_V); const bf16_t* Q = (const bf16_t*)(a->ws + WS_Q);
    LAS bf16_t* vT = (LAS bf16_t*)lds;
    LAS bf16_t* sT = (LAS bf16_t*)(lds + 67584);
    LAS bf16_t* qd = (LAS bf16_t*)(lds + 102400);
    LAS bf16_t* ki = (LAS bf16_t*)(lds + 111104);
    LAS bf16_t* keT = (LAS bf16_t*)(lds + 119808);
    LAS bf16_t* sc = (LAS bf16_t*)(lds + 130048);
    LAS float* de = (LAS float*)(lds + 132608);
    LAS float* ssq = (LAS float*)(lds + 133120);
    const int lane = tid & 63, wave = __builtin_amdgcn_readfirstlane(tid >> 6), fr = lane & 15, fq = lane >> 4;
    __syncthreads();
    hgrn_stage_vT(V, vT, r0, 1, hh, tid);
    const int kc0 = (wave * 8 + (lane & 7)) * 2, part = lane >> 3;
    f32x4 osum[8][2];
    f32x2 lfN[4]; unsigned qN[4];
#define HC_ISSUE(dirn, jbn) do { _Pragma("unroll") for (int t = 0; t < 4; ++t) { const int row = r0 + 32 * (jbn) + 4 * part + t; \
        lfN[t] = *(const f32x2*)(LF + (size_t)row * 2048 + (dirn) * 1024 + hh * 128 + kc0); qN[t] = *(const unsigned*)(Q + (size_t)row * 1024 + hh * 128 + kc0); } } while (0)
#define HC_BAR() asm volatile("s_waitcnt lgkmcnt(0)\n\ts_barrier" ::: "memory")
    HC_ISSUE(0, 0);
#pragma unroll 1
    for (int dir = 0; dir < 2; ++dir) {
        const int chain = (b * 8 + hh) * 2 + dir, slot = dir ? 15 - cl : cl;
        f32x4 Sacc[8];
        { const float* stp = (const float*)(a->ws + WS_ST2) + ((size_t)(chain * 16 + slot) * 128 + 16 * wave + fr) * 128 + 4 * fq;
#pragma unroll
          for (int n = 0; n < 8; ++n) { Sacc[n] = *(const f32x4*)(stp + 16 * n); u32x2 w; w.x = pk2(Sacc[n][0], Sacc[n][1]); w.y = pk2(Sacc[n][2], Sacc[n][3]); *(LAS u32x2*)(sT + (16 * wave + fr) * ST_LD + 16 * n + 4 * fq) = w; } }
#pragma unroll
        for (int j = 0; j < 8; ++j) {
            const int jb = dir ? 7 - j : j;
            { f32x2 lf[4]; float qx[4], qy[4];
#pragma unroll
              for (int t = 0; t < 4; ++t) { lf[t] = lfN[t]; const unsigned qw = qN[t]; qx[t] = bflo(qw); qy[t] = bfhi(qw); }
              asm volatile("" ::: "memory");
              if (j < 7) HC_ISSUE(dir, dir ? 6 - j : j + 1); else if (dir == 0) HC_ISSUE(1, 7);
              asm volatile("" ::: "memory");
              f32x2 p[4], run = {0.f, 0.f};
#pragma unroll
              for (int t = 0; t < 4; ++t) { run += lf[t]; p[t] = run; }
              f32x2 off = {0.f, 0.f}, total = {0.f, 0.f};
#pragma unroll
              for (int q = 0; q < 8; ++q) { const float sx = __shfl(run.x, (lane & 7) + 8 * q), sy = __shfl(run.y, (lane & 7) + 8 * q); total.x += sx; total.y += sy; if (q < part) { off.x += sx; off.y += sy; } }
              float kex[4], key[4];
#pragma unroll
              for (int t = 0; t < 4; ++t) {
                  const float clx = dir ? total.x - (off.x + p[t].x) + lf[t].x : off.x + p[t].x, cly = dir ? total.y - (off.y + p[t].y) + lf[t].y : off.y + p[t].y;
                  const float kx = 1.0f - __expf(lf[t].x), ky = 1.0f - __expf(lf[t].y); const int i = 4 * part + t;
                  *(LAS unsigned*)(qd + i * ST_LD + kc0) = pk2(qx[t] * __expf(clx), qy[t] * __expf(cly)); *(LAS unsigned*)(ki + i * ST_LD + kc0) = pk2(kx * __expf(-clx), ky * __expf(-cly));
                  kex[t] = kx * __expf(total.x - clx); key[t] = ky * __expf(total.y - cly); }
              { u32x2 w; w.x = pk2(kex[0], kex[1]); w.y = pk2(kex[2], kex[3]); *(LAS u32x2*)(keT + kc0 * KE_LD + 4 * part) = w; w.x = pk2(key[0], key[1]); w.y = pk2(key[2], key[3]); *(LAS u32x2*)(keT + (kc0 + 1) * KE_LD + 4 * part) = w; }
              if (part == 0) *(LAS f32x2*)(de + kc0) = (f32x2){__expf(total.x), __expf(total.y)}; }
            HC_BAR();
            f32x4 o[2] = {(f32x4){0.f, 0.f, 0.f, 0.f}, (f32x4){0.f, 0.f, 0.f, 0.f}};
#pragma unroll
            for (int ks = 0; ks < 4; ++ks) { const bf16x8 sf = *(const LAS bf16x8*)(sT + (16 * wave + fr) * ST_LD + 32 * ks + 8 * fq);
#pragma unroll
                for (int mi = 0; mi < 2; ++mi) { const bf16x8 qf = *(const LAS bf16x8*)(qd + (16 * mi + fr) * ST_LD + 32 * ks + 8 * fq); o[mi] = __builtin_amdgcn_mfma_f32_16x16x32_bf16(sf, qf, o[mi], 0, 0, 0); } }
            if (wave < 4) { const int mi = wave >> 1, ni = wave & 1; f32x4 sa = {0.f, 0.f, 0.f, 0.f};
#pragma unroll
                for (int ks = 0; ks < 4; ++ks) { const bf16x8 kf = *(const LAS bf16x8*)(ki + (16 * ni + fr) * ST_LD + 32 * ks + 8 * fq), qf = *(const LAS bf16x8*)(qd + (16 * mi + fr) * ST_LD + 32 * ks + 8 * fq);
                    sa = __builtin_amdgcn_mfma_f32_16x16x32_bf16(kf, qf, sa, 0, 0, 0); }
                const int ii = 16 * mi + fr, jp = 16 * ni + 4 * fq; u32x2 w;
                const bool k0 = dir ? (jp + 0 >= ii) : (jp + 0 <= ii), k1 = dir ? (jp + 1 >= ii) : (jp + 1 <= ii), k2 = dir ? (jp + 2 >= ii) : (jp + 2 <= ii), k3 = dir ? (jp + 3 >= ii) : (jp + 3 <= ii);
                w.x = pk2(k0 ? sa[0] : 0.f, k1 ? sa[1] : 0.f); w.y = pk2(k2 ? sa[2] : 0.f, k3 ? sa[3] : 0.f);
                *(LAS u32x2*)(sc + ii * KE_LD + jp) = w; }
            HC_BAR();
            { const bf16x8 vf = *(const LAS bf16x8*)(vT + (16 * wave + fr) * VT_LD + 32 * jb + 8 * fq);
#pragma unroll
              for (int mi = 0; mi < 2; ++mi) { const bf16x8 sf2 = *(const LAS bf16x8*)(sc + (16 * mi + fr) * KE_LD + 8 * fq); o[mi] = __builtin_amdgcn_mfma_f32_16x16x32_bf16(vf, sf2, o[mi], 0, 0, 0); }
              if (dir == 0) { osum[j][0] = o[0]; osum[j][1] = o[1]; } else { osum[7 - j][0] += o[0]; osum[7 - j][1] += o[1]; }
#pragma unroll
              for (int n = 0; n < 8; ++n) { const f32x4 d4 = *(const LAS f32x4*)(de + 16 * n + 4 * fq); const bf16x8 kf = *(const LAS bf16x8*)(keT + (16 * n + fr) * KE_LD + 8 * fq);
                  Sacc[n] = Sacc[n] * d4; Sacc[n] = __builtin_amdgcn_mfma_f32_16x16x32_bf16(kf, vf, Sacc[n], 0, 0, 0);
                  u32x2 w; w.x = pk2(Sacc[n][0], Sacc[n][1]); w.y = pk2(Sacc[n][2], Sacc[n][3]); *(LAS u32x2*)(sT + (16 * wave + fr) * ST_LD + 16 * n + 4 * fq) = w; } }
            HC_BAR();
        }
    }
#pragma unroll
    for (int jb = 0; jb < 8; ++jb)
#pragma unroll
        for (int mi = 0; mi < 2; ++mi) { const f32x4 v = osum[jb][mi]; float s = (v[0] * v[0] + v[1] * v[1]) + (v[2] * v[2] + v[3] * v[3]); s += __shfl_xor(s, 16); s += __shfl_xor(s, 32);
            if (fq == 0) ssq[(32 * jb + 16 * mi + fr) * 8 + wave] = s; }
    __syncthreads();
    { const bf16_t* G = (const bf16_t*)(a->ws + WS_G); bf16_t* MIX = (bf16_t*)(a->ws + WS_MIX + LOFF(1)); const int vc0 = hh * 128 + 16 * wave + 4 * fq;
      const f32x4 on = *(const f32x4*)(a->in[I_ONORM] + vc0);
#pragma unroll
      for (int jb = 0; jb < 8; ++jb)
#pragma unroll
          for (int mi = 0; mi < 2; ++mi) { const int t = 32 * jb + 16 * mi + fr; const f32x4 s0 = *(const LAS f32x4*)(ssq + t * 8), s1 = *(const LAS f32x4*)(ssq + t * 8 + 4);
              const float rs = rsqrtf(((s0[0] + s0[1]) + (s0[2] + s0[3]) + (s1[0] + s1[1]) + (s1[2] + s1[3])) * (1.0f / 128.0f) + EPS);
              const u32x2 gw = *(const u32x2*)(G + (size_t)(r0 + t) * 1024 + vc0); const f32x4 v = osum[jb][mi];
              u32x2 w; w.x = pk2(v[0] * rs * on[0] * bflo(gw.x), v[1] * rs * on[1] * bfhi(gw.x)); w.y = pk2(v[2] * rs * on[2] * bflo(gw.y), v[3] * rs * on[3] * bfhi(gw.y));
              *(u32x2*)(MIX + (size_t)(r0 + t) * D + vc0) = w; } }
}
__device__ __forceinline__ int lru_tile(int b, int dir, int p) { return p < 4 ? 128 + 4 * b + (dir ? 3 - p : p) : 64 * b + (dir ? 63 - (p - 4) : p - 4); }
struct LruW { bf16x8 f[2][2][4]; };
__device__ __forceinline__ void lru_A_unit(KA a, LAS unsigned char* lds, int unit, int tid, LruW& wf, int& cur_hh) {
    const int hh = unit & 7, tl = unit >> 3, r0 = tl * 64;
    const bf16_t* LX = (const bf16_t*)(a->ws + WS_LX);
    LAS bf16_t* xcb = (LAS bf16_t*)lds;
    const int lane = tid & 63, wave = __builtin_amdgcn_readfirstlane(tid >> 6), fr = lane & 15, fq = lane >> 4;
    const int seq0 = r0 < NLAT ? (r0 & ~(SEQ - 1)) : NLAT + ((r0 - NLAT) & ~(CTXL - 1)), seqlen = r0 < NLAT ? SEQ : CTXL;
    if (hh != cur_hh) { cur_hh = hh;
#pragma unroll
        for (int dm = 0; dm < 4; ++dm)
#pragma unroll
            for (int ks = 0; ks < 4; ++ks) wf.f[dm >> 1][dm & 1][ks] = *(const bf16x8*)((const bf16_t*)(a->ws + WS_WRT) + ((size_t)(dm * 8 + hh) * 128 + 16 * wave + fr) * 128 + 32 * ks + 8 * fq); }
    __syncthreads();
    {
        const int c = (tid & 63) * 2, t0 = (tid >> 6) * 8, ch2 = hh * 128 + c, pos0 = r0 + t0 - seq0;
        f32x2 cw[4];
#pragma unroll
        for (int jj = 0; jj < 4; ++jj) cw[jj] = *(const f32x2*)(a->in[I_CONVW] + jj * 1024 + ch2);
        const f32x2 cb = *(const f32x2*)(a->in[I_CONVB] + ch2);
        float x0[11], x1[11];
#pragma unroll
        for (int q = 0; q < 11; ++q) { const int p = pos0 + q - 2; unsigned w = 0u; if (p >= 0 && p < seqlen) w = *(const unsigned*)(LX + (size_t)(seq0 + p) * 1024 + ch2); x0[q] = bflo(w); x1[q] = bfhi(w); }
#pragma unroll
        for (int q = 0; q < 8; ++q) { float s0 = cb.x, s1 = cb.y;
#pragma unroll
            for (int jj = 0; jj < 4; ++jj) { s0 += cw[jj].x * x0[q + jj]; s1 += cw[jj].y * x1[q + jj]; }
            *(LAS unsigned*)(xcb + (t0 + q) * XC_LD + c) = pk2(s0, s1); }
    }
    __syncthreads();
    const int j = 16 * wave + fr, ch = hh * 128 + j;
    LAS bf16_t* las = (LAS bf16_t*)(lds + 17408); LAS bf16_t* lus = (LAS bf16_t*)(lds + 33792);
    bf16x8 af[4][4];
#pragma unroll
    for (int ks = 0; ks < 4; ++ks)
#pragma unroll
        for (int m = 0; m < 4; ++m) af[ks][m] = *(const LAS bf16x8*)(xcb + (16 * m + fr) * XC_LD + 32 * ks + 8 * fq);
    float xcv[4][4];
#pragma unroll
    for (int m = 0; m < 4; ++m)
#pragma unroll
        for (int r = 0; r < 4; ++r) xcv[m][r] = bf1(xcb[(16 * m + 4 * fq + r) * XC_LD + j]);
#pragma unroll
    for (int dir = 0; dir < 2; ++dir) {
        f32x4 acc[2][4];
#pragma unroll
        for (int mat = 0; mat < 2; ++mat)
#pragma unroll
            for (int m = 0; m < 4; ++m) { acc[mat][m] = (f32x4){0.f, 0.f, 0.f, 0.f};
#pragma unroll
                for (int ks = 0; ks < 4; ++ks) acc[mat][m] = __builtin_amdgcn_mfma_f32_16x16x32_bf16(af[ks][m], wf.f[dir][mat][ks], acc[mat][m], 0, 0, 0); }
        const float br = a->in[I_BR][dir * 1024 + ch], bi = a->in[I_BI][dir * 1024 + ch]; const float el = __expf(-a->in[I_LAM][dir * 1024 + ch]), sp = el < 0.03f ? el * (1.0f - el * (0.5f - el * (1.0f / 3.0f))) : __logf(1.0f + el);
        float la[4][4], uu[4][4], g[4];
#pragma unroll
        for (int m = 0; m < 4; ++m) { g[m] = 0.f;
#pragma unroll
            for (int r = 0; r < 4; ++r) { const int t = 16 * m + 4 * fq + r; const float rg = sigmoidf_(acc[0][m][r] + br), ig = sigmoidf_(acc[1][m][r] + bi); la[m][r] = -8.0f * rg * sp;
                uu[m][r] = sqrtf(1.0f - __expf(2.0f * la[m][r])) * (ig * xcv[m][r]); g[m] += la[m][r];
                las[t * 128 + j] = (bf16_t)(pk2(la[m][r], 0.f) & 0xffffu); lus[t * 128 + j] = (bf16_t)(pk2(uu[m][r], 0.f) & 0xffffu); } }
        float P = 0.f, X[4];
#pragma unroll
        for (int m = 0; m < 4; ++m) { X[m] = P;
#pragma unroll
            for (int f = 0; f < 4; ++f) { const float gv = __shfl(g[m], fr + 16 * f); if (f < fq) X[m] += gv; P += gv; } }
        float E = 0.f;
#pragma unroll
        for (int m = 0; m < 4; ++m) { float c = X[m];
#pragma unroll
            for (int r = 0; r < 4; ++r) { c += la[m][r]; E += uu[m][r] * __expf(dir == 0 ? (P - c) : (c - la[m][r])); } }
        E += __shfl_xor(E, 16); E += __shfl_xor(E, 32);
        if (fq == 0) { ((float*)(a->ws + WS_PS))[((size_t)dir * 136 + tl) * 1024 + ch] = P; ((float*)(a->ws + WS_ES))[((size_t)dir * 136 + tl) * 1024 + ch] = E; }
        __syncthreads();
        { bf16_t* LA = (bf16_t*)(a->ws + WS_LA) + (size_t)dir * NTOK * 1024; bf16_t* LU = (bf16_t*)(a->ws + WS_LU) + (size_t)dir * NTOK * 1024;
#pragma unroll
          for (int q = 0; q < 2; ++q) { const int i = tid + q * NTHR, t = i >> 4, c8 = (i & 15) * 8;
              *(u32x4*)(LA + (size_t)(r0 + t) * 1024 + hh * 128 + c8) = *(const LAS u32x4*)(las + t * 128 + c8); *(u32x4*)(LU + (size_t)(r0 + t) * 1024 + hh * 128 + c8) = *(const LAS u32x4*)(lus + t * 128 + c8); } }
        if (dir == 0) __syncthreads();
    }
}
__device__ __forceinline__ void lru_B(KA a, int gt) {
    if (gt >= NB * 2 * 1024) return;
    const int ch = gt & 1023, dir = (gt >> 10) & 1, b = gt >> 11;
    const float* PS = (const float*)(a->ws + WS_PS) + (size_t)dir * 136 * 1024 + ch; const float* ES = (const float*)(a->ws + WS_ES) + (size_t)dir * 136 * 1024 + ch;
    float* HI = (float*)(a->ws + WS_HI) + (size_t)dir * 136 * 1024 + ch;
    float h = 0.f;
#pragma unroll 17
    for (int p = 0; p < 68; ++p) { const int tl = lru_tile(b, dir, p); HI[(size_t)tl * 1024] = h; h = __expf(PS[(size_t)tl * 1024]) * h + ES[(size_t)tl * 1024]; }
}
__device__ __forceinline__ void lru_C(KA a, LAS unsigned char* lds, int tid, int bid, int G) {
    const bf16_t* LG = (const bf16_t*)(a->ws + WS_LG); bf16_t* MIX = (bf16_t*)(a->ws + WS_MIX + LOFF(1));
    LAS f32x2* hfs = (LAS f32x2*)lds;
    const int cp = tid & 255, role = tid >> 8;
    for (int item = bid; item < 256; item += G) {
        const int tl = item >> 1, ch = (item & 1) * 512 + 2 * cp, r0 = tl * 64;
        __syncthreads();
        if (role == 0) {
            const bf16_t* la = (const bf16_t*)(a->ws + WS_LA) + (size_t)r0 * 1024 + ch; const bf16_t* lu = (const bf16_t*)(a->ws + WS_LU) + (size_t)r0 * 1024 + ch;
            f32x2 h = *(const f32x2*)((const float*)(a->ws + WS_HI) + (size_t)tl * 1024 + ch);
#pragma unroll 16
            for (int t = 0; t < 64; ++t) { const unsigned wa = *(const unsigned*)la, wu = *(const unsigned*)lu; la += 1024; lu += 1024;
                h.x = __expf(bflo(wa)) * h.x + bflo(wu); h.y = __expf(bfhi(wa)) * h.y + bfhi(wu); hfs[t * 256 + cp] = h; }
            __syncthreads();
        } else {
            const bf16_t* la = (const bf16_t*)(a->ws + WS_LA) + (size_t)(NTOK + r0 + 63) * 1024 + ch; const bf16_t* lu = (const bf16_t*)(a->ws + WS_LU) + (size_t)(NTOK + r0 + 63) * 1024 + ch;
            f32x2 h = *(const f32x2*)((const float*)(a->ws + WS_HI) + (size_t)(136 + tl) * 1024 + ch);
            f32x2 hb[64];
#pragma unroll
            for (int t = 63; t >= 0; --t) { const unsigned wa = *(const unsigned*)la, wu = *(const unsigned*)lu; la -= 1024; lu -= 1024;
                h.x = __expf(bflo(wa)) * h.x + bflo(wu); h.y = __expf(bfhi(wa)) * h.y + bfhi(wu); hb[t] = h; if ((t & 15) == 0) asm volatile("" ::: "memory"); }
            __syncthreads();
            const bf16_t* lg = LG + (size_t)r0 * 1024 + ch; bf16_t* mx = MIX + (size_t)r0 * D + 1024 + ch;
#pragma unroll
            for (int t = 0; t < 64; ++t) { const f32x2 hf = hfs[t * 256 + cp]; const unsigned wg = *(const unsigned*)(lg + (size_t)t * 1024);
                *(unsigned*)(mx + (size_t)t * D) = pk2((hf.x + hb[t].x) * bflo(wg), (hf.y + hb[t].y) * bfhi(wg)); if ((t & 15) == 15) asm volatile("" ::: "memory"); }
        }
    }
}
#ifndef PHMASK
#define PHMASK 0x1FFFFFu
#endif
#define HAS(k) (((PHMASK) >> (k)) & 1u)
#define IN(k) (HAS(k) && lo <= (k) && (k) < hi)
#define SEAM(k) do { if (lo <= (k) && (k) + 1 < hi) xcd_barrier(bar); } while (0)
#define LAUNDER() int tid = wave * 64 + (int)__builtin_amdgcn_mbcnt_hi(~0u, __builtin_amdgcn_mbcnt_lo(~0u, 0u)); asm volatile("" : "+v"(tid)); int G = G0, bid = bid0; asm volatile("" : "+s"(G), "+s"(bid)); const int lane = tid & 63, gt = bid * NTHR + tid, gw = bid * NWAVES + wave, ngw = G * NWAVES, ngt = G * NTHR; (void)lane; (void)gt; (void)gw; (void)ngw; (void)ngt
template <int LAYER>
__device__ __forceinline__ void shared_phases(LAS unsigned char* lds, const int lo, const int hi, const XcdBarrier& bar, LAS int* tpre, LAS int* tcnt, const int wave, const int G0, const int bid0) {
    constexpr int layer = LAYER, sb = LAYER == 0 ? 6 : 15;
    constexpr int nrows = LAYER == 0 ? NTOK : NLAT;
    if (HAS(6) && lo <= sb && sb < hi) {
        LAUNDER(); KA a = get_args(); unsigned char* ws = a->ws;
        pg8::SchedPlain S{(const char*)(ws + WS_MIX + LOFF(layer)), (const char*)(ws + WS_WOUT) + (size_t)layer * D * D * 2, D, D, nrows / 256, D / 256, D, G, bid};
        EpiRaw E{(bf16_t*)(ws + WS_O + LOFF(layer)), D};
        pg8::gemm_phase<EpiRaw, pg8::SchedPlain, false>(lds, S, E, tid);
        if (LAYER == 0 && G == 256 && bid >= FILL6_B0) { const int base = TR_NIT - TR_F6 + (bid - FILL6_B0) * 8 * FILL6_PERW; tr_run(a, ws, base + wave, base + 8 * FILL6_PERW, 8, lane); }
    } SEAM(sb);
    if (HAS(7) && lo <= sb + 1 && sb + 1 < hi) { LAUNDER(); KA a = get_args(); phase_row1(a, layer, nrows, bid, G, wave, lane, lds); __syncthreads(); } SEAM(sb + 1);
    if (HAS(8) && lo <= sb + 2 && sb + 2 < hi) {
        LAUNDER(); KA a = get_args(); unsigned char* ws = a->ws;
        moe_tables(a, layer, tpre, tcnt);
        SchedGU S{(const char*)(ws + WS_H2 + LOFF(layer)), (const char*)(ws + WS_WGU) + (size_t)layer * NE * 2048 * D * 2, (const int*)(ws + WS_LIST + LOFF(layer)), tpre, tcnt, D, 64, G, bid};
        EpiGU E{(bf16_t*)(ws + WS_ACT + LOFF(layer)), a->in[I_BGU] + (size_t)layer * NE * 2048};
        pg8::gemm_phase<EpiGU, SchedGU, true>(lds, S, E, tid);
    } SEAM(sb + 2);
    if (HAS(9) && lo <= sb + 3 && sb + 3 < hi) {
        LAUNDER(); KA a = get_args(); unsigned char* ws = a->ws;
        moe_tables(a, layer, tpre, tcnt);
        SchedDown S{(const char*)(ws + WS_ACT + LOFF(layer)), (const char*)(ws + WS_WDN) + (size_t)layer * NE * D * DE * 2, tpre, tcnt, 64, 64, G, bid};
        EpiDown E{(bf16_t*)(ws + WS_YS + LOFF(layer)), a->in[I_BDN] + (size_t)layer * NE * D};
        pg8::gemm_phase<EpiDown, SchedDown, false>(lds, S, E, tid);
    } SEAM(sb + 3);
    if (HAS(10) && lo <= sb + 4 && sb + 4 < hi) { LAUNDER(); KA a = get_args(); moe_tables(a, layer, tpre, tcnt); phase_combine(a, layer, nrows, gw, ngw, lane, tid, lds, tpre); } SEAM(sb + 4);
}

__global__ void __launch_bounds__(NTHR, 2) fwd(Args args_unused) {
    extern __shared__ __attribute__((aligned(16))) unsigned char smem[];
    LAS unsigned char* lds = (LAS unsigned char*)smem;
    const int tid0 = threadIdx.x, wave = __builtin_amdgcn_readfirstlane(tid0 >> 6);
    const int G0 = gridDim.x, bid0 = blockIdx.x;
    volatile LAS unsigned* MISC = (volatile LAS unsigned*)(lds + MISC_OFF);
    LAS int* tpre = (LAS int*)(lds + MISC_OFF + 64); LAS int* tcnt = (LAS int*)(lds + MISC_OFF + 64 + 256);
    if (tid0 < 4) MISC[tid0] = 0u;
    __syncthreads();
    int lo, hi; XcdBarrier bar;
    { KA a = get_args(); lo = a->ph_lo; hi = a->ph_hi; bar.bar = (unsigned*)(a->ws + WS_CTL) + CW_BAR; bar.x = 0; bar.st = MISC;
      if (hi - lo > 1) bar = xcd_barrier_post((unsigned*)(a->ws + WS_CTL) + CW_BAR, MISC); }
#define SEAM(k) do { if (lo <= (k) && (k) + 1 < hi) xcd_barrier(bar); } while (0)

    if (IN(0)) { LAUNDER(); KA a = get_args(); phase_prologue(a, gw, ngw, lane);    } SEAM(0);
    if (IN(1)) { LAUNDER(); KA a = get_args(); phase_modfinal(a, gt, ngt);    } SEAM(1);
    if (IN(2)) { LAUNDER(); KA a = get_args(); phase_h0(a, gw, ngw, lane, tid, lds);    } SEAM(2);

    if (IN(3)) {
        LAUNDER(); KA a = get_args(); unsigned char* ws = a->ws;
        pg8::SchedPlain S{(const char*)(ws + WS_H), (const char*)(ws + WS_WABIN), D, D, NTOK / 256, AB_COLS / 256, D, G, bid};
        EpiAbIn E{(bf16_t*)(ws + WS_PA), (bf16_t*)(ws + WS_PZ)};
        pg8::gemm_phase<EpiAbIn, pg8::SchedPlain, false>(lds, S, E, tid);
        if (G == 256 && bid >= FILL3_B0) { const int base = TR_NIT - TR_F6 - TR_F3 + (bid - FILL3_B0) * 8 * FILL3_PERW; tr_run(a, ws, base + wave, base + 8 * FILL3_PERW, 8, lane); }
    } SEAM(3);
    if (IN(4)) {
        LAUNDER(); KA a = get_args(); unsigned char* ws = a->ws;
        { SchedChan S{(const char*)(ws + WS_F256), (const char*)(ws + WS_PA), 256, 1024, G, bid}; EpiChan E{(bf16_t*)(ws + WS_ZT)};
          pg8::gemm_phase<EpiChan, SchedChan, false>(lds, S, E, tid); }
        { SchedChanC S{(const char*)(ws + WS_F256), (const char*)(ws + WS_PA), 256, 1024, G, (bid + 16) % G}; EpiChanC E{(bf16_t*)(ws + WS_ZTC)};
          pg8::gemm_phase<EpiChanC, SchedChanC, false>(lds, S, E, tid); }
        gmlp_stats(a, gw, ngw, lane);
        __syncthreads();
    } SEAM(4);
    if (IN(5)) {
        LAUNDER(); KA a = get_args(); unsigned char* ws = a->ws;
        for (int u = bid; u < 256; u += G) fft_unit(a, lds, u, tid);
        __syncthreads();
        { SchedPosC S{(const char*)(ws + WS_DLC), (const char*)(ws + WS_ZTC), 512, 512, G, (bid + 128) % G}; EpiPos E{(bf16_t*)(ws + WS_MIX)};
          pg8::gemm_phase<EpiPos, SchedPosC, false>(lds, S, E, tid); }
        { int cur_hh = -1; for (int u = bid; u < 68 * 8; u += G) gmlp_unit(a, lds, u >> 3, u & 7, cur_hh, tid, lane, wave);
          __syncthreads(); }
    } SEAM(5);

    shared_phases<0>(lds, lo, hi, bar, tpre, tcnt, wave, G0, bid0);
    if (IN(11)) {
        LAUNDER(); KA a = get_args(); unsigned char* ws = a->ws;
        pg8::SchedPlain S{(const char*)(ws + WS_H + LOFF(1)), (const char*)(ws + WS_WCDIN), D, D, NTOK / 256, CD_COLS / 256, D, G, bid};
        EpiCdIn E{(bf16_t*)(ws + WS_Q), (bf16_t*)(ws + WS_V), (bf16_t*)(ws + WS_G), (bf16_t*)(ws + WS_LG), (bf16_t*)(ws + WS_LX), (float*)(ws + WS_LF), a->in[I_LB]};
        pg8::gemm_phase<EpiCdIn, pg8::SchedPlain, false>(lds, S, E, tid);
        if (G == 256 && bid >= FILL11_B0) { const int base = TR_NIT - TR_FILL + (bid - FILL11_B0) * 8 * FILL11_PERW; tr_run(a, ws, base + wave, base + 8 * FILL11_PERW, 8, lane); }
    } SEAM(11);
    if (IN(12)) {
        LAUNDER(); KA a = get_args();
        for (int u = bid; u < 512; u += G) hgrn_A_unit(a, lds, u, tid);
        { LruW wf; int cur_hh = -1; for (int u = bid; u < (NTOK / 64) * 8; u += G) lru_A_unit(a, lds, u, tid, wf, cur_hh); }
        __syncthreads();
    } SEAM(12);
    if (IN(13)) { LAUNDER(); KA a = get_args(); hgrn_B(a, gt, ngt); lru_B(a, gt);    } SEAM(13);
    if (IN(14)) {
        LAUNDER(); KA a = get_args();
        for (int u = bid; u < 256; u += G) hgrn_C_unit(a, lds, u, tid);
        __syncthreads();
        lru_C(a, lds, tid, bid, G);
    } SEAM(14);

    shared_phases<1>(lds, lo, hi, bar, tpre, tcnt, wave, G0, bid0);
#undef IN
#undef SEAM
}

#ifndef N_LAUNCH_MODE
#define N_LAUNCH_MODE 1
#endif
extern "C" void kernel_launch(void* const* d_in, const int* in_sizes, int n_in, void* d_out, int out_size, void* d_ws, size_t ws_size, hipStream_t stream) {
    static int grid = 0;
    if (grid == 0) {
        if (n_in != 29 || out_size != NLAT * D || ws_size < WS_END) { fprintf(stderr, "kernel_launch: unexpected shapes (n_in %d out %d ws %zu need %zu)\n", n_in, out_size, ws_size, (size_t)WS_END); grid = -1; return; }
        int dev = 0, cus = 0, per_cu = 0;
        if (hipGetDevice(&dev) != hipSuccess || hipDeviceGetAttribute(&cus, hipDeviceAttributeMultiprocessorCount, dev) != hipSuccess) { grid = -1; return; }
        if (hipFuncSetAttribute((const void*)fwd, hipFuncAttributeMaxDynamicSharedMemorySize, LDS_BYTES) != hipSuccess) { fprintf(stderr, "kernel_launch: hipFuncSetAttribute failed\n"); grid = -1; return; }
        if (hipOccupancyMaxActiveBlocksPerMultiprocessor(&per_cu, (const void*)fwd, NTHR, LDS_BYTES) != hipSuccess || per_cu < 1) fprintf(stderr, "kernel_launch: occupancy query reports %d\n", per_cu);
        (void)hipGetLastError();
        grid = cus;
    }
    if (grid < 0) return;
    (void)hipMemsetAsync((char*)d_ws + WS_CTL, 0, CTL_BYTES, stream);
    Args a{};
    for (int i = 0; i < 29; ++i) a.in[i] = (const float*)d_in[i];
    a.out = (float*)d_out; a.ws = (unsigned char*)d_ws;
#if N_LAUNCH_MODE == 1
    a.ph_lo = 0; a.ph_hi = NPH;
    hipLaunchKernelGGL(fwd, dim3(grid), dim3(NTHR), LDS_BYTES, stream, a);
#else
    for (int p = 0; p < NPH; ++p) { a.ph_lo = p; a.ph_hi = p + 1; hipLaunchKernelGGL(fwd, dim3(grid), dim3(NTHR), LDS_BYTES, stream, a); }
#endif
    const hipError_t le = hipPeekAtLastError();
    if (le != hipSuccess) fprintf(stderr, "kernel_launch: launch failed: %s\n", hipGetErrorName(le));
}
```

```cpp
#include <hip/hip_runtime.h>
#include <cstdio>
#include <cstdint>

#define LAS __attribute__((address_space(3)))
typedef unsigned short bf16_t;
typedef short bf16x8 __attribute__((ext_vector_type(8)));
typedef float f32x4 __attribute__((ext_vector_type(4)));
typedef float f32x2 __attribute__((ext_vector_type(2)));
typedef unsigned u32x4 __attribute__((ext_vector_type(4)));
typedef unsigned u32x2 __attribute__((ext_vector_type(2)));

constexpr int D = 2048, NB = 2, SEQ = 4096, CTXL = 256, NLAT = NB * SEQ, NCTX = NB * CTXL, NTOK = NLAT + NCTX;
constexpr int NE = 32, DE = 1024, LCAP = NTOK;
constexpr int AB_COLS = 3072, CD_COLS = 7168;
constexpr int MAXTILES = 168, NSLOT = MAXTILES * 256;
constexpr float EPS = 1e-6f;
constexpr int NWAVES = 8, NTHR = 512;
constexpr int LDS_STAGE = 131072, MISC_OFF = 145408, LDS_BYTES = 147456;
constexpr int NPH = 20;
constexpr int KSPLIT = 16;

constexpr size_t al256(size_t x) { return (x + 255) & ~(size_t)255; }
constexpr size_t WS_CTL = 0, CTL_BYTES = 65536;
constexpr size_t WS_MODP = WS_CTL + CTL_BYTES;
constexpr size_t WS_MODV = WS_MODP + al256((size_t)KSPLIT * 2 * 3 * 6 * D * 4);
constexpr size_t WS_WABIN = WS_MODV + al256((size_t)2 * 3 * 6 * D * 4);
constexpr size_t WS_WOUT = WS_WABIN + (size_t)AB_COLS * D * 2;
constexpr size_t WS_WCDIN = WS_WOUT + (size_t)2 * D * D * 2;
constexpr size_t WS_WGU = WS_WCDIN + (size_t)CD_COLS * D * 2;
constexpr size_t WS_WDN = WS_WGU + (size_t)2 * NE * 2048 * D * 2;
constexpr size_t WS_FA = WS_WDN + (size_t)2 * NE * D * DE * 2;
constexpr size_t WS_GC = WS_FA + (size_t)128 * 128 * 2;
constexpr size_t WS_DLC = WS_GC + (size_t)64 * 128 * 2;
constexpr size_t WS_F256 = WS_DLC + (size_t)256 * 512 * 2;
constexpr size_t WS_XL = WS_F256 + (size_t)512 * 256 * 2;
constexpr size_t WS_H = WS_XL + (size_t)NTOK * D * 4;
constexpr size_t WS_PA = WS_H + (size_t)NTOK * D * 2;
constexpr size_t WS_PZ = WS_PA + (size_t)NTOK * 1024 * 2;
constexpr size_t WS_ZT = WS_PZ + (size_t)NTOK * 2048 * 2;
constexpr size_t WS_ZTC = WS_ZT + (size_t)2 * 1024 * 2 * 4096 * 2;
constexpr size_t WS_MIX = WS_ZTC + (size_t)2 * 1024 * 2 * 256 * 2;
constexpr size_t WS_O = WS_MIX + (size_t)NTOK * D * 2;
constexpr size_t WS_TOKE = WS_O + (size_t)NTOK * D * 2;
constexpr size_t WS_TOKR = WS_TOKE + al256((size_t)NTOK * 4 * 4);
constexpr size_t WS_TOKP = WS_TOKR + al256((size_t)NTOK * 4 * 4);
constexpr size_t WS_LIST = WS_TOKP + al256((size_t)NTOK * 4 * 4);
constexpr size_t WS_ACT = WS_LIST + al256((size_t)NE * LCAP * 4);
constexpr size_t WS_YS = WS_ACT + (size_t)NSLOT * DE * 2;
constexpr size_t WS_H2 = WS_YS + (size_t)NSLOT * D * 2;
constexpr size_t WS_Q = WS_H2 + (size_t)NTOK * D * 2;
constexpr size_t WS_LF = WS_Q + (size_t)NTOK * 1024 * 2;
constexpr size_t WS_V = WS_LF + (size_t)NTOK * 2048 * 4;
constexpr size_t WS_G = WS_V + (size_t)NTOK * 1024 * 2;
constexpr size_t WS_LG = WS_G + (size_t)NTOK * 1024 * 2;
constexpr size_t WS_LX = WS_LG + (size_t)NTOK * 1024 * 2;
constexpr size_t WS_LA = WS_LX + (size_t)NTOK * 1024 * 2;
constexpr size_t WS_LU = WS_LA + (size_t)2 * NTOK * 1024 * 4;
constexpr size_t WS_OD = WS_LU + (size_t)2 * NTOK * 1024 * 4;
constexpr size_t WS_HS = WS_OD + (size_t)2 * NLAT * 1024 * 4;
constexpr size_t WS_ST = WS_HS + (size_t)2 * NLAT * 1024 * 4;
constexpr size_t WS_DT = WS_ST + (size_t)32 * 16 * 128 * 128 * 4;
constexpr size_t WS_ST2 = WS_DT + (size_t)32 * 16 * 128 * 4;
constexpr size_t WS_WRT = WS_ST2 + (size_t)32 * 16 * 128 * 128 * 4;
constexpr size_t WS_PS = WS_WRT + (size_t)2 * 2 * 8 * 128 * 128 * 2;
constexpr size_t WS_ES = WS_PS + (size_t)2 * 136 * 1024 * 4;
constexpr size_t WS_HI = WS_ES + (size_t)2 * 136 * 1024 * 4;
constexpr size_t WS_GST = WS_HI + (size_t)2 * 136 * 1024 * 4;
constexpr size_t WS_RWH = WS_GST + (size_t)NTOK * 2 * 4;
constexpr size_t WS_RWL = WS_RWH + (size_t)2 * 32 * 2048 * 2;
constexpr size_t WS_RGN1 = WS_RWL + (size_t)2 * 32 * 2048 * 2;
constexpr size_t WS_END = WS_RGN1 + (WS_Q - WS_H);
__host__ __device__ constexpr size_t LOFF(int layer) { return layer ? (WS_RGN1 - WS_H) : 0; }

#define XB_TMO      128
#define XB_XCNT(j)  (256  + 64 * (j))
#define XB_XSUB(j)  (1280 + 64 * (j))
#define XB_XGEN(j)  (2304 + 64 * (j))
#define XB_TOP      3328
#define XB_TOPGEN   3392
#define XCD_BAR_WORDS 3456
#define XB_SPIN_CAP (1u << 22)
constexpr int CW_BAR = 0, CW_CNT = 4096, CNT_STRIDE = 32;

__device__ __forceinline__ unsigned xb_ld(unsigned* p)              { return __hip_atomic_load(p, __ATOMIC_RELAXED, __HIP_MEMORY_SCOPE_AGENT); }
__device__ __forceinline__ unsigned xb_add(unsigned* p, unsigned v) { return __hip_atomic_fetch_add(p, v, __ATOMIC_RELAXED, __HIP_MEMORY_SCOPE_AGENT); }
__device__ __forceinline__ unsigned xb_xcc_id() { return (unsigned)__builtin_amdgcn_s_getreg((3 << 11) | 20) & 0xFu; }
#define XB_SPIN(cond, bar) do { unsigned _sp = 0; while (cond) { __builtin_amdgcn_s_sleep(1); \
    if ((++_sp & 255u) == 0u) { if (xb_ld(&(bar)[XB_TMO])) break; if (_sp > XB_SPIN_CAP) { atomicAdd(&(bar)[XB_TMO], 1u); break; } } } } while (0)
struct XcdBarrier { unsigned* bar; unsigned x; volatile LAS unsigned* st; };
__device__ __forceinline__ XcdBarrier xcd_barrier_post(unsigned* bar, volatile LAS unsigned* st) {
    XcdBarrier b; b.bar = bar; b.x = xb_xcc_id(); b.st = st;
    if (threadIdx.x == 0) (void)xb_add(&bar[XB_XCNT(b.x)], 1u);
    return b;
}
__device__ __forceinline__ void xcd_barrier_complete(unsigned* bar, unsigned x, unsigned& nloc, unsigned& nx) {
    const unsigned G = gridDim.x * gridDim.y * gridDim.z;
    unsigned sum, cnt, mine, sp = 0u;
    for (;;) {
        sum = 0u; cnt = 0u; mine = 0u;
#pragma unroll
        for (unsigned j = 0; j < 16; ++j) { const unsigned c = xb_ld(&bar[XB_XCNT(j)]); sum += c; cnt += (c > 0u) ? 1u : 0u; mine = (j == x) ? c : mine; }
        if (sum == G) break;
        __builtin_amdgcn_s_sleep(1);
        if ((++sp & 255u) == 0u) { if (xb_ld(&bar[XB_TMO])) break; if (sp > XB_SPIN_CAP) { atomicAdd(&bar[XB_TMO], 1u); break; } }
    }
    nloc = mine > 0u ? mine : 1u; nx = cnt > 0u ? cnt : 1u;
}
__device__ __forceinline__ void xcd_barrier(const XcdBarrier& b) {
    asm volatile("s_waitcnt vmcnt(0)" ::: "memory");
    __syncthreads();
    if (threadIdx.x == 0) {
        unsigned* bar = b.bar;
        __builtin_amdgcn_s_waitcnt(0);
        unsigned nloc = b.st[0], nx = b.st[1];
        if (nloc == 0u) { xcd_barrier_complete(bar, b.x, nloc, nx); b.st[0] = nloc; b.st[1] = nx; }
        const unsigned old = xb_add(&bar[XB_XSUB(b.x)], 1u);
        const unsigned gen = old / nloc;
        if (old + 1u == (gen + 1u) * nloc) {
            __builtin_amdgcn_fence(__ATOMIC_RELEASE, "agent");
            asm volatile("s_waitcnt vmcnt(0)" ::: "memory");
            const unsigned og = xb_add(&bar[XB_TOP], 1u);
            const unsigned tg = og / nx;
            if (og + 1u == (tg + 1u) * nx) xb_add(&bar[XB_TOPGEN], 1u);
            else XB_SPIN(xb_ld(&bar[XB_TOPGEN]) == tg, bar);
            __builtin_amdgcn_fence(__ATOMIC_ACQUIRE, "agent");
            xb_add(&bar[XB_XGEN(b.x)], 1u);
            asm volatile("s_waitcnt vmcnt(0)" ::: "memory");
        } else {
            XB_SPIN(xb_ld(&bar[XB_XGEN(b.x)]) == gen, bar);
            __builtin_amdgcn_fence(__ATOMIC_ACQUIRE, "agent");
            asm volatile("s_waitcnt vmcnt(0)" ::: "memory");
        }
    }
    __syncthreads();
}

typedef __bf16 bf16x2_t __attribute__((ext_vector_type(2)));
__device__ __forceinline__ unsigned pk2(float lo, float hi) { const f32x2 v = {lo, hi}; return __builtin_bit_cast(unsigned, __builtin_convertvector(v, bf16x2_t)); }
__device__ __forceinline__ float bflo(unsigned w) { return __uint_as_float(w << 16); }
__device__ __forceinline__ float bfhi(unsigned w) { return __uint_as_float(w & 0xffff0000u); }
__device__ __forceinline__ float bf1(bf16_t b) { return __uint_as_float((unsigned)b << 16); }
__device__ __forceinline__ float wave_sum(float v) {
#pragma unroll
    for (int o = 1; o < 64; o <<= 1) v += __shfl_xor(v, o);
    return v;
}
__device__ __forceinline__ float rdl(float v, int l) { return __uint_as_float((unsigned)__builtin_amdgcn_readlane((int)__float_as_uint(v), l)); }
__device__ __forceinline__ float sigmoidf_(float x) { return __builtin_amdgcn_rcpf(1.0f + __expf(-x)); }
__device__ __forceinline__ float siluf_(float x) { return x * sigmoidf_(x); }
__device__ __forceinline__ float gelu_tanh(float x) { const float y = 1.5957691216057308f * (x + 0.044715f * x * x * x); return x * sigmoidf_(y); }

namespace pg8 {
constexpr int BM = 256, BK = 64, HALF = 128, HTB = HALF * BK * 2, STAGE_BYTES = 8 * HTB;
__device__ __forceinline__ int lds_byte(int r, int c) { const int st = (r >> 4) * 2 + (c >> 5), rr = r & 15, cc = c & 31, ob = rr * 64 + cc * 2; return st * 1024 + (ob ^ (((ob >> 9) & 1) << 5)); }
__device__ __forceinline__ void stage_rc(int b, int& R, int& C) { const int st = b / 1024, sb = b % 1024, swz = sb ^ (((sb >> 9) & 1) << 5); R = (st >> 1) * 16 + swz / 64; C = (st & 1) * 32 + (swz % 64) / 2; }
__device__ __forceinline__ int perm32(int rho) { const int n = rho >> 4, i = rho & 15; return 8 * (i >> 2) + 4 * n + (i & 3); }
struct LanePos { int R[2], C[2]; };
template <bool GATHER> struct UnitAO { unsigned ao[2][2]; };
template <> struct UnitAO<false> {};
template <bool GATHER> struct Unit : UnitAO<GATHER> {
    unsigned a0, a1, b0, b1;
    int nt;
    int full;
    int p0, p1, p2;
};
template <bool GATHER> __device__ __forceinline__ unsigned unit_ao(const Unit<GATHER>& u, int h, int i, const unsigned (&voffA)[2]) { if constexpr (GATHER) return u.ao[h][i]; else return voffA[i]; }
template <class Epi, class Sched, bool GATHER>
__device__ __forceinline__ void gemm_phase(LAS unsigned char* lds, const Sched& S, const Epi& E, int tid_in) {
    int tid = tid_in; asm volatile("" : "+v"(tid));
    const int wid = __builtin_amdgcn_readfirstlane(tid >> 6), lane = tid & 63, wr = wid >> 2, wc = wid & 3, fr = lane & 15, fq = lane >> 4;
    LanePos lp; unsigned voffB[2], voffA[2];
#pragma unroll
    for (int i = 0; i < 2; ++i) { int R, C; stage_rc(tid * 16 + i * 8192, R, C); lp.R[i] = R; lp.C[i] = C; const int Rb = (R & ~31) + perm32(R & 31); voffB[i] = (unsigned)(S.brow(Rb) * S.ldb + C) * 2u; voffA[i] = (unsigned)(R * S.lda + C) * 2u; }
    const unsigned kstep = (unsigned)(BK * 2); constexpr unsigned kstepB = Sched::KSTEPB, kstepA = Sched::KSTEPA;
    const unsigned ldsw = (unsigned)wid * 1024u;
    const int aoff = lds_byte(wr * 64 + fr, fq * 8), boff = lds_byte(wc * 32 + fr, fq * 8);
    const char* const Abase = S.Abase; const char* const Bbase = S.Bbase;
#define PG8_SA(b, h) (((b) * 2 + (h)) * HTB)
#define PG8_SB(b, h) ((4 + (b) * 2 + (h)) * HTB)
#define PG8_STAGE(bufoff, gbase, o0, o1) do { \
        __builtin_amdgcn_global_load_lds((const unsigned*)((gbase) + (o0)), (LAS unsigned*)(lds + (bufoff) + ldsw), 16, 0, 0); \
        __builtin_amdgcn_global_load_lds((const unsigned*)((gbase) + (o1)), (LAS unsigned*)(lds + (bufoff) + ldsw + 8192), 16, 0, 0); } while (0)
#define PG8_STAGE_B(bufoff, uoff) PG8_STAGE(bufoff, Bbase + (size_t)(uoff), voffB[0], voffB[1])
#define PG8_STAGE_A(bufoff, uoff, o0, o1) PG8_STAGE(bufoff, Abase + (size_t)(uoff), o0, o1)
#define PG8_AO(U, h, i) unit_ao<GATHER>(U, h, i, voffA)
#define PG8_LDA(dst, b, h) do { _Pragma("unroll") for (int m = 0; m < 4; ++m) _Pragma("unroll") for (int k = 0; k < 2; ++k) dst[m][k] = *(const LAS bf16x8*)(lds + PG8_SA(b, h) + aoff + m * 2048 + k * 1024); } while (0)
#define PG8_LDB(dst, b, h) do { _Pragma("unroll") for (int n = 0; n < 2; ++n) _Pragma("unroll") for (int k = 0; k < 2; ++k) dst[n][k] = *(const LAS bf16x8*)(lds + PG8_SB(b, h) + boff + n * 2048 + k * 1024); } while (0)
#define PG8_MMA(ai, bj, At, Bt) do { __builtin_amdgcn_s_setprio(1); _Pragma("unroll") for (int m = 0; m < 4; ++m) _Pragma("unroll") for (int n = 0; n < 2; ++n) _Pragma("unroll") for (int k = 0; k < 2; ++k) \
        acc[ai][bj][m][n] = __builtin_amdgcn_mfma_f32_16x16x32_bf16(Bt[n][k], At[m][k], acc[ai][bj][m][n], 0, 0, 0); __builtin_amdgcn_s_setprio(0); } while (0)
#define PG8_WAIT_V(n) asm volatile("s_waitcnt vmcnt(" #n ")" ::: "memory")
#define PG8_WAIT_L(n) asm volatile("s_waitcnt lgkmcnt(" #n ")" ::: "memory")
#define PG8_BAR __builtin_amdgcn_s_barrier()
#define PG8_SCHED __builtin_amdgcn_sched_barrier(0)
    Unit<GATHER> cur, nxt; int ui = 0;
    if (!S.next(0, cur, lp)) return;
    f32x4 acc[2][2][4][2];
#pragma unroll
    for (int a = 0; a < 2; ++a)
#pragma unroll
        for (int b = 0; b < 2; ++b)
#pragma unroll
            for (int m = 0; m < 4; ++m)
#pragma unroll
                for (int n = 0; n < 2; ++n) acc[a][b][m][n] = (f32x4){0.f, 0.f, 0.f, 0.f};
    bf16x8 At[4][2], B0[2][2], B1[2][2];
    PG8_STAGE_B(PG8_SB(0, 0), cur.b0); PG8_STAGE_B(PG8_SB(0, 1), cur.b1); PG8_STAGE_A(PG8_SA(0, 0), cur.a0, PG8_AO(cur, 0, 0), PG8_AO(cur, 0, 1)); PG8_STAGE_A(PG8_SA(0, 1), cur.a1, PG8_AO(cur, 1, 0), PG8_AO(cur, 1, 1));
    if (wr == 1) PG8_BAR;
    PG8_WAIT_V(2); PG8_BAR;
    PG8_STAGE_B(PG8_SB(1, 0), cur.b0 + kstepB); PG8_STAGE_A(PG8_SA(1, 0), cur.a0 + kstepA, PG8_AO(cur, 0, 0), PG8_AO(cur, 0, 1)); PG8_STAGE_B(PG8_SB(1, 1), cur.b1 + kstepB);
    PG8_WAIT_V(6); PG8_BAR;
    for (;;) {
        const bool has_next = S.next(ui + 1, nxt, lp);
        if (!has_next) nxt = cur;
        const int nt = cur.nt; const bool full = cur.full != 0;
#define PG8_TRIP(FULL) do { \
              \
            PG8_LDB(B0, 0, 0); PG8_LDB(B1, 0, 1); PG8_SCHED; PG8_LDA(At, 0, 0); PG8_STAGE_A(PG8_SA(1, 1), cur.a1 + k1, PG8_AO(cur, 1, 0), PG8_AO(cur, 1, 1)); \
            PG8_WAIT_V(8); PG8_WAIT_L(0); PG8_BAR; PG8_MMA(0, 0, At, B0); PG8_MMA(0, 1, At, B1); PG8_BAR; PG8_SCHED; \
              \
            PG8_LDA(At, 0, 1); PG8_STAGE_B(PG8_SB(0, 0), b0n); PG8_STAGE_B(PG8_SB(0, 1), b1n); PG8_STAGE_A(PG8_SA(0, 0), a0n, o00, o01); \
            PG8_WAIT_V(8); PG8_WAIT_L(0); PG8_BAR; if (FULL) { PG8_MMA(1, 0, At, B0); PG8_MMA(1, 1, At, B1); } PG8_BAR; PG8_SCHED; \
              \
            PG8_LDB(B0, 1, 0); PG8_LDB(B1, 1, 1); PG8_SCHED; PG8_LDA(At, 1, 0); PG8_STAGE_A(PG8_SA(0, 1), a1n, o10, o11); \
            PG8_WAIT_V(8); PG8_WAIT_L(0); PG8_BAR; PG8_MMA(0, 0, At, B0); PG8_MMA(0, 1, At, B1); PG8_BAR; PG8_SCHED; \
              \
            PG8_LDA(At, 1, 1); PG8_STAGE_B(PG8_SB(1, 0), b0n + kstepB); PG8_STAGE_B(PG8_SB(1, 1), b1n + kstepB); PG8_STAGE_A(PG8_SA(1, 0), a0n + kstepA, o00, o01); \
            PG8_WAIT_V(8); PG8_WAIT_L(0); PG8_BAR; if (FULL) { PG8_MMA(1, 0, At, B0); PG8_MMA(1, 1, At, B1); } PG8_BAR; PG8_SCHED; } while (0)
        if (full) { for (int t = 0; t < nt; t += 2) {
            const bool last = (t == nt - 2);
            const unsigned k1 = (unsigned)(t + 1) * kstepA, k2 = (unsigned)(t + 2) * kstepA, k2b = (unsigned)(t + 2) * kstepB;
            const unsigned a0n = last ? nxt.a0 : cur.a0 + k2, a1n = last ? nxt.a1 : cur.a1 + k2, b0n = last ? nxt.b0 : cur.b0 + k2b, b1n = last ? nxt.b1 : cur.b1 + k2b;
            const unsigned o00 = last ? PG8_AO(nxt, 0, 0) : PG8_AO(cur, 0, 0), o01 = last ? PG8_AO(nxt, 0, 1) : PG8_AO(cur, 0, 1), o10 = last ? PG8_AO(nxt, 1, 0) : PG8_AO(cur, 1, 0), o11 = last ? PG8_AO(nxt, 1, 1) : PG8_AO(cur, 1, 1);
            PG8_TRIP(true); } }
        else { for (int t = 0; t < nt; t += 2) {
            const bool last = (t == nt - 2);
            const unsigned k1 = (unsigned)(t + 1) * kstepA, k2 = (unsigned)(t + 2) * kstepA, k2b = (unsigned)(t + 2) * kstepB;
            const unsigned a0n = last ? nxt.a0 : cur.a0 + k2, a1n = last ? nxt.a1 : cur.a1 + k2, b0n = last ? nxt.b0 : cur.b0 + k2b, b1n = last ? nxt.b1 : cur.b1 + k2b;
            const unsigned o00 = last ? PG8_AO(nxt, 0, 0) : PG8_AO(cur, 0, 0), o01 = last ? PG8_AO(nxt, 0, 1) : PG8_AO(cur, 0, 1), o10 = last ? PG8_AO(nxt, 1, 0) : PG8_AO(cur, 1, 0), o11 = last ? PG8_AO(nxt, 1, 1) : PG8_AO(cur, 1, 1);
            PG8_TRIP(false); } }
#undef PG8_TRIP
        if (wr == 0) PG8_BAR;
        E(acc, cur, wr, wc, fr, fq);
        if (!has_next) break;
#pragma unroll
        for (int a = 0; a < 2; ++a)
#pragma unroll
            for (int b = 0; b < 2; ++b)
#pragma unroll
                for (int m = 0; m < 4; ++m)
#pragma unroll
                    for (int n = 0; n < 2; ++n) acc[a][b][m][n] = (f32x4){0.f, 0.f, 0.f, 0.f};
        cur = nxt; ++ui;
        if (wr == 1) PG8_BAR;
    }
    PG8_WAIT_V(0);
    PG8_BAR;
#undef PG8_SA
#undef PG8_SB
#undef PG8_STAGE
#undef PG8_STAGE_A
#undef PG8_STAGE_B
#undef PG8_AO
#undef PG8_LDA
#undef PG8_LDB
#undef PG8_MMA
#undef PG8_WAIT_V
#undef PG8_WAIT_L
#undef PG8_BAR
#undef PG8_SCHED
}

__device__ __forceinline__ bool static_tile(int i, int G, int c, int nM, int nN, int& pm, int& pn) {
    const int nwg = nM * nN; const long L = (long)i * G + c; if (L >= nwg) return false;
    int wgid = (int)L; { const int q = nwg / 8, r = nwg % 8, xcd = wgid % 8, off = wgid / 8; wgid = (xcd < r ? xcd * (q + 1) : r * (q + 1) + (xcd - r) * q) + off; }
    const int nig = 8 * nN, gid = wgid / nig, fm = gid * 8, gsz = (nM - fm) < 8 ? (nM - fm) : 8;
    pm = fm + ((wgid % nig) % gsz); pn = (wgid % nig) / gsz; return true;
}
struct SchedPlain {
    static constexpr unsigned KSTEPA = 128u;
    static constexpr unsigned KSTEPB = 128u;
    const char* Abase; const char* Bbase; int lda, ldb, nM, nN, K, G, c;
    __device__ __forceinline__ int brow(int r) const { return r; }
    __device__ __forceinline__ bool next(int i, Unit<false>& u, const LanePos& lp) const {
        int pm, pn; if (!static_tile(i, G, c, nM, nN, pm, pn)) return false;
        u.a0 = (unsigned)(pm * 256 * lda) * 2u; u.a1 = u.a0 + (unsigned)(128 * lda) * 2u;
        u.b0 = (unsigned)(pn * 256 * ldb) * 2u; u.b1 = u.b0 + (unsigned)(128 * ldb) * 2u;
        u.nt = K / BK; u.full = 1; u.p0 = pm; u.p1 = pn; u.p2 = 0; return true;
    }
};
}
using pg8::Unit;

#define EPI_LOOP_ROWS for (int ai = 0; ai < 2; ++ai) _Pragma("unroll") for (int m = 0; m < 4; ++m)
struct EpiRaw {
    bf16_t* O; int ldc;
    __device__ __forceinline__ void operator()(const f32x4 (&acc)[2][2][4][2], const Unit<false>& u, int wr, int wc, int fr, int fq) const {
        const int row0 = u.p0 * 256 + wr * 64 + fr, col0 = u.p1 * 256 + wc * 32 + 8 * fq;
#pragma unroll
        EPI_LOOP_ROWS { bf16_t* rowp = O + (size_t)(row0 + ai * 128 + m * 16) * ldc + col0;
#pragma unroll
            for (int bj = 0; bj < 2; ++bj) { const f32x4 v0 = acc[ai][bj][m][0], v1 = acc[ai][bj][m][1];
                u32x4 w; w.x = pk2(v0[0], v0[1]); w.y = pk2(v0[2], v0[3]); w.z = pk2(v1[0], v1[1]); w.w = pk2(v1[2], v1[3]); *(u32x4*)(rowp + bj * 128) = w; } }
    }
};
struct EpiAbIn {
    bf16_t* PA; bf16_t* PZ;
    __device__ __forceinline__ void operator()(const f32x4 (&acc)[2][2][4][2], const Unit<false>& u, int wr, int wc, int fr, int fq) const {
        const int row0 = u.p0 * 256 + wr * 64 + fr; const bool isz = u.p1 >= 4;
        bf16_t* base = isz ? PZ : PA; const int ldc = isz ? 2048 : 1024; const int col0 = (isz ? (u.p1 - 4) : u.p1) * 256 + wc * 32 + 8 * fq;
#pragma unroll
        EPI_LOOP_ROWS { bf16_t* rowp = base + (size_t)(row0 + ai * 128 + m * 16) * ldc + col0;
#pragma unroll
            for (int bj = 0; bj < 2; ++bj) { f32x4 v0 = acc[ai][bj][m][0], v1 = acc[ai][bj][m][1];
                if (isz) {
#pragma unroll
                    for (int j = 0; j < 4; ++j) { v0[j] = gelu_tanh(v0[j]); v1[j] = gelu_tanh(v1[j]); } }
                u32x4 w; w.x = pk2(v0[0], v0[1]); w.y = pk2(v0[2], v0[3]); w.z = pk2(v1[0], v1[1]); w.w = pk2(v1[2], v1[3]); *(u32x4*)(rowp + bj * 128) = w; } }
    }
};
struct EpiChan {
    bf16_t* ZT;
    __device__ __forceinline__ void operator()(const f32x4 (&acc)[2][2][4][2], const Unit<false>& u, int wr, int wc, int fr, int fq) const {
        const int ri = u.p0, tt = u.p1, g = u.p2, b = tt >> 4, tq = tt & 15;
#pragma unroll
        EPI_LOOP_ROWS { const int j = ai * 128 + wr * 64 + m * 16 + fr;
#pragma unroll
            for (int bj = 0; bj < 2; ++bj) { const int col0 = bj * 128 + wc * 32 + 8 * fq, l2 = 4 * tq + (col0 >> 6), l1 = col0 & 63; const f32x4 v0 = acc[ai][bj][m][0], v1 = acc[ai][bj][m][1];
                u32x4 w; w.x = pk2(v0[0], v0[1]); w.y = pk2(v0[2], v0[3]); w.z = pk2(v1[0], v1[1]); w.w = pk2(v1[2], v1[3]);
                *(u32x4*)(ZT + ((((size_t)(b * 1024 + g * 256 + j) * 64 + l2) * 2 + ri) * 64 + l1)) = w; } }
    }
};
struct EpiChanC {
    bf16_t* ZTC;
    __device__ __forceinline__ void operator()(const f32x4 (&acc)[2][2][4][2], const Unit<false>& u, int wr, int wc, int fr, int fq) const {
        const int ri = u.p0, b = u.p1, g = u.p2, l0 = wc * 32 + 8 * fq;
#pragma unroll
        EPI_LOOP_ROWS { const int j = ai * 128 + wr * 64 + m * 16 + fr;
            bf16_t* rowp = ZTC + ((size_t)((b * 1024 + g * 256 + j) * 2 + ri)) * 256 + l0;
#pragma unroll
            for (int bj = 0; bj < 2; ++bj) { const f32x4 v0 = acc[ai][bj][m][0], v1 = acc[ai][bj][m][1];
                u32x4 w; w.x = pk2(v0[0], v0[1]); w.y = pk2(v0[2], v0[3]); w.z = pk2(v1[0], v1[1]); w.w = pk2(v1[2], v1[3]); *(u32x4*)(rowp + bj * 128) = w; } }
    }
};
struct EpiPos {
    bf16_t* MIX;
    __device__ __forceinline__ void operator()(const f32x4 (&acc)[2][2][4][2], const Unit<false>& u, int wr, int wc, int fr, int fq) const {
        const int row0 = u.p0 + wr * 64 + fr, col0 = u.p1 * 256 + wc * 32 + 8 * fq;
#pragma unroll
        EPI_LOOP_ROWS { bf16_t* rowp = MIX + (size_t)(row0 + ai * 128 + m * 16) * D + col0;
#pragma unroll
            for (int bj = 0; bj < 2; ++bj) { const f32x4 v0 = acc[ai][bj][m][0], v1 = acc[ai][bj][m][1];
                u32x4 w; w.x = pk2(v0[0], v0[1]); w.y = pk2(v0[2], v0[3]); w.z = pk2(v1[0], v1[1]); w.w = pk2(v1[2], v1[3]); *(u32x4*)(rowp + bj * 128) = w; } }
    }
};
struct EpiGU {
    bf16_t* ACT; const float* bgu;
    __device__ __forceinline__ void operator()(const f32x4 (&acc)[2][2][4][2], const Unit<true>& u, int wr, int wc, int fr, int fq) const {
        const int row0 = u.p0 + wr * 64 + fr, c0 = u.p1 * 128 + wc * 32 + 8 * fq;
        const float* bg = bgu + (size_t)u.p2 * 2048 + c0; const float* bu = bg + 1024;
        const f32x4 g0 = *(const f32x4*)bg, g1 = *(const f32x4*)(bg + 4), u0 = *(const f32x4*)bu, u1 = *(const f32x4*)(bu + 4);
#pragma unroll
        EPI_LOOP_ROWS { bf16_t* rowp = ACT + ((size_t)(((u.p0 >> 8) * 2 + ai) * 16 + u.p1 * 2 + (wc >> 1)) * 128 + wr * 64 + m * 16 + fr) * 64 + (wc & 1) * 32 + 8 * fq;
            float o[8];
#pragma unroll
            for (int j = 0; j < 4; ++j) {
                { const float gt = fminf(acc[ai][0][m][0][j] + g0[j], 7.0f); const float up = fminf(fmaxf(acc[ai][1][m][0][j] + u0[j], -7.0f), 7.0f); o[j] = gt * sigmoidf_(1.702f * gt) * (up + 1.0f); }
                { const float gt = fminf(acc[ai][0][m][1][j] + g1[j], 7.0f); const float up = fminf(fmaxf(acc[ai][1][m][1][j] + u1[j], -7.0f), 7.0f); o[4 + j] = gt * sigmoidf_(1.702f * gt) * (up + 1.0f); } }
            u32x4 w; w.x = pk2(o[0], o[1]); w.y = pk2(o[2], o[3]); w.z = pk2(o[4], o[5]); w.w = pk2(o[6], o[7]); *(u32x4*)rowp = w; }
    }
};
struct EpiDown {
    bf16_t* YS; const float* bdn;
    __device__ __forceinline__ void operator()(const f32x4 (&acc)[2][2][4][2], const Unit<false>& u, int wr, int wc, int fr, int fq) const {
        const int row0 = u.p0 + wr * 64 + fr, col0 = u.p1 * 256 + wc * 32 + 8 * fq;
        const float* bp = bdn + (size_t)u.p2 * 2048 + col0;
        f32x4 bv[2][2];
#pragma unroll
        for (int bj = 0; bj < 2; ++bj) { bv[bj][0] = *(const f32x4*)(bp + bj * 128); bv[bj][1] = *(const f32x4*)(bp + bj * 128 + 4); }
#pragma unroll
        EPI_LOOP_ROWS { bf16_t* rowp = YS + (size_t)(row0 + ai * 128 + m * 16) * D + col0;
#pragma unroll
            for (int bj = 0; bj < 2; ++bj) { const f32x4 v0 = acc[ai][bj][m][0] + bv[bj][0], v1 = acc[ai][bj][m][1] + bv[bj][1];
                u32x4 w; w.x = pk2(v0[0], v0[1]); w.y = pk2(v0[2], v0[3]); w.z = pk2(v1[0], v1[1]); w.w = pk2(v1[2], v1[3]); *(u32x4*)(rowp + bj * 128) = w; } }
    }
};
struct EpiCdIn {
    bf16_t *Q, *V, *G, *LG, *LX; float* LF; const float* lbraw;
    __device__ __forceinline__ void operator()(const f32x4 (&acc)[2][2][4][2], const Unit<false>& u, int wr, int wc, int fr, int fq) const {
        const int row0 = u.p0 * 256 + wr * 64 + fr, pn = u.p1;
        if (pn >= 4 && pn < 12) {
            const int col0 = (pn - 4) * 256 + wc * 32 + 8 * fq;
            float lb[2][8];
#pragma unroll
            for (int bj = 0; bj < 2; ++bj)
#pragma unroll
                for (int j = 0; j < 8; ++j) { const int kc = (col0 + bj * 128 + j) & 1023; lb[bj][j] = sigmoidf_(lbraw[1024 + kc] - lbraw[kc]); }
#pragma unroll
            EPI_LOOP_ROWS { float* rowp = LF + (size_t)(row0 + ai * 128 + m * 16) * 2048 + col0;
#pragma unroll
                for (int bj = 0; bj < 2; ++bj) { f32x4 o0, o1;
#pragma unroll
                    for (int j = 0; j < 4; ++j) { o0[j] = __logf(lb[bj][j] + (1.0f - lb[bj][j]) * sigmoidf_(acc[ai][bj][m][0][j])); o1[j] = __logf(lb[bj][4 + j] + (1.0f - lb[bj][4 + j]) * sigmoidf_(acc[ai][bj][m][1][j])); }
                    *(f32x4*)(rowp + bj * 128) = o0; *(f32x4*)(rowp + bj * 128 + 4) = o1; } }
            return;
        }
        int act, tl; bf16_t* base;
        if (pn < 4) { base = Q; act = 1; tl = pn; } else if (pn < 16) { base = V; act = 0; tl = pn - 12; } else if (pn < 20) { base = G; act = 1; tl = pn - 16; }
        else if (pn < 24) { base = LG; act = 2; tl = pn - 20; } else { base = LX; act = 0; tl = pn - 24; }
        const int col0 = tl * 256 + wc * 32 + 8 * fq;
#pragma unroll
        EPI_LOOP_ROWS { bf16_t* rowp = base + (size_t)(row0 + ai * 128 + m * 16) * 1024 + col0;
#pragma unroll
            for (int bj = 0; bj < 2; ++bj) { f32x4 v0 = acc[ai][bj][m][0], v1 = acc[ai][bj][m][1];
                if (act == 1) {
#pragma unroll
                    for (int j = 0; j < 4; ++j) { v0[j] = siluf_(v0[j]); v1[j] = siluf_(v1[j]); } }
                if (act == 2) {
#pragma unroll
                    for (int j = 0; j < 4; ++j) { v0[j] = gelu_tanh(v0[j]); v1[j] = gelu_tanh(v1[j]); } }
                u32x4 w; w.x = pk2(v0[0], v0[1]); w.y = pk2(v0[2], v0[3]); w.z = pk2(v1[0], v1[1]); w.w = pk2(v1[2], v1[3]); *(u32x4*)(rowp + bj * 128) = w; } }
    }
};

struct SchedChan {
    static constexpr unsigned KSTEPA = 128u;
    static constexpr unsigned KSTEPB = 128u;
    const char* Abase; const char* Bbase; int lda, ldb, G, c;
    __device__ __forceinline__ int brow(int r) const { return 64 * (r & 63) + (r >> 6); }
    __device__ __forceinline__ bool next(int i, Unit<false>& u, const pg8::LanePos& lp) const {
        const int L = i * G + c; if (L >= 4 * 2 * 32) return false;
        const int tt = L & 31, ri = (L >> 5) & 1, g = L >> 6, b = tt >> 4, tq = tt & 15;
        u.a0 = (unsigned)(ri * 256 * 256) * 2u; u.a1 = u.a0 + (unsigned)(128 * 256) * 2u;
        u.b0 = (unsigned)((b * 4096 + 4 * tq) * 1024 + g * 256) * 2u; u.b1 = u.b0 + (unsigned)(2 * 1024) * 2u;
        u.nt = 4; u.full = 1; u.p0 = ri; u.p1 = tt; u.p2 = g; return true;
    }
};
struct SchedChanC {
    static constexpr unsigned KSTEPA = 128u;
    static constexpr unsigned KSTEPB = 128u;
    const char* Abase; const char* Bbase; int lda, ldb, G, c;
    __device__ __forceinline__ int brow(int r) const { return r; }
    __device__ __forceinline__ bool next(int i, Unit<false>& u, const pg8::LanePos& lp) const {
        const int L = i * G + c; if (L >= 4 * 2 * 2) return false;
        const int b = L & 1, ri = (L >> 1) & 1, g = L >> 2;
        u.a0 = (unsigned)(ri * 256 * 256) * 2u; u.a1 = u.a0 + (unsigned)(128 * 256) * 2u;
        u.b0 = (unsigned)((NLAT + b * 256) * 1024 + g * 256) * 2u; u.b1 = u.b0 + (unsigned)(128 * 1024) * 2u;
        u.nt = 4; u.full = 1; u.p0 = ri; u.p1 = b; u.p2 = g; return true;
    }
};
struct SchedPosC {
    static constexpr unsigned KSTEPA = 128u;
    static constexpr unsigned KSTEPB = 128u;
    const char* Abase; const char* Bbase; int lda, ldb, G, c;
    __device__ __forceinline__ int brow(int r) const { return r; }
    __device__ __forceinline__ bool next(int i, Unit<false>& u, const pg8::LanePos& lp) const {
        const int L = i * G + c; if (L >= 8) return false;
        const int b = L >> 2, pn = L & 3;
        u.a0 = 0u; u.a1 = 128u * 512u * 2u;
        u.b0 = (unsigned)(b * 1024 + pn * 256) * 512u * 2u; u.b1 = u.b0 + 128u * 512u * 2u;
        u.nt = 8; u.full = 1; u.p0 = NLAT + b * 256; u.p1 = pn; u.p2 = 0; return true;
    }
};
struct SchedGU {
    static constexpr unsigned KSTEPA = 128u;
    static constexpr unsigned KSTEPB = 16384u;
    const char* Abase; const char* Bbase; const int* list; const LAS int* tpre; const LAS int* tcnt; int lda, ldb, G, c;
    __device__ __forceinline__ int brow(int r) const { return r; }
    __device__ __forceinline__ bool next(int i, Unit<true>& u, const pg8::LanePos& lp) const {
        const int ntile = tpre[32]; int ti, pn;
        if ((G & 255) == 0) { const int x = c & 7, y = (c >> 3) & 31, blk = c >> 8; ti = 32 * (i * (G >> 8) + blk) + 8 * (x >> 1) + (y >> 2); pn = 4 * (x & 1) + (y & 3); }
        else { const int L = i * G + c; ti = L >> 3; pn = L & 7; }
        if (ti >= ntile) return false;
        int e = 0;
        for (int q = 1; q < 32; ++q) e += (tpre[q] <= ti) ? 1 : 0;
        const int mt = ti - tpre[e], cnt = tcnt[e];
        u.a0 = 0u; u.a1 = 0u;
#pragma unroll
        for (int h = 0; h < 2; ++h)
#pragma unroll
            for (int p = 0; p < 2; ++p) { int rk = mt * 256 + h * 128 + lp.R[p]; rk = rk < cnt ? rk : cnt - 1; const int tok = list[e * LCAP + rk]; u.ao[h][p] = (unsigned)(tok * D + lp.C[p]) * 2u; }
        u.b0 = (unsigned)(e * 2048 * D + pn * (D / 64) * 8192) * 2u; u.b1 = u.b0 + (unsigned)(8 * (D / 64) * 8192) * 2u;
        u.nt = D / 64; u.full = (cnt - mt * 256 > 128) ? 1 : 0; u.p0 = ti * 256; u.p1 = pn; u.p2 = e; return true;
    }
};
struct SchedDown {
    static constexpr unsigned KSTEPA = 16384u;
    static constexpr unsigned KSTEPB = 16384u;
    const char* Abase; const char* Bbase; const LAS int* tpre; const LAS int* tcnt; int lda, ldb, G, c;
    __device__ __forceinline__ int brow(int r) const { return r; }
    __device__ __forceinline__ bool next(int i, Unit<false>& u, const pg8::LanePos& lp) const {
        const int ntile = tpre[32]; int ti, pn;
        if ((G & 255) == 0) { const int x = c & 7, y = (c >> 3) & 31, blk = c >> 8; ti = 32 * (i * (G >> 8) + blk) + 8 * (x >> 1) + (y >> 2); pn = 4 * (x & 1) + (y & 3); }
        else { const int L = i * G + c; ti = L >> 3; pn = L & 7; }
        if (ti >= ntile) return false;
        int e = 0;
        for (int q = 1; q < 32; ++q) e += (tpre[q] <= ti) ? 1 : 0;
        const int full = (tcnt[e] - (ti - tpre[e]) * 256 > 128) ? 1 : 0;
        u.a0 = (unsigned)(ti * 256 * DE) * 2u; u.a1 = full ? u.a0 + (unsigned)(128 * DE) * 2u : u.a0;
        u.b0 = (unsigned)(e * 2048 * DE + 2 * pn * (DE / 64) * 8192) * 2u; u.b1 = u.b0 + (unsigned)((DE / 64) * 8192) * 2u;
        u.nt = DE / 64; u.full = full; u.p0 = ti * 256; u.p1 = pn; u.p2 = e; return true;
    }
};

struct Args { const float* in[29]; float* out; unsigned char* ws; int ph_lo, ph_hi; };
typedef const __attribute__((address_space(4))) Args* KA;
__device__ __forceinline__ KA get_args() { KA p = (KA)__builtin_amdgcn_kernarg_segment_ptr(); asm volatile("" : "+s"(p)); return p; }
enum { I_X = 0, I_C, I_CTX, I_CCTX, I_MODW, I_MODB, I_NORMG, I_ABIN, I_ABOUT, I_VG, I_WS, I_BS, I_CDIN, I_CDOUT, I_LB, I_ONORM, I_CONVW, I_CONVB, I_WR, I_BR, I_WI, I_BI, I_LAM,
       I_RW, I_RB, I_WGU, I_BGU, I_WDN, I_BDN };

struct TrItem { const float* src; bf16_t* dst; int dj, N, db; };
template <bool GROUP8 = true, bool TILED = false>
__device__ __forceinline__ void tr_set(TrItem& t, const float* W, int K, int N, bf16_t* WT, int item, int lane) {
    const int nblk = N >> 5, nb = GROUP8 ? ((item >> 3) % (nblk >> 3)) * 8 + (item & 7) : item % nblk, kb = GROUP8 ? (item >> 3) / (nblk >> 3) : item / nblk, k0 = kb * 128, n0 = nb * 32, nq = lane & 7, ko = lane >> 3;
    t.src = W + (size_t)(k0 + 8 * ko) * N + n0 + 4 * nq; t.N = N;
    if (TILED) { t.dst = WT + ((size_t)((n0 >> 7) * (K >> 6) + 2 * kb) * 128 + (n0 & 127) + 4 * nq) * 64 + 8 * ko; t.dj = 64; t.db = 8192; }
    else { t.dst = WT + (size_t)(n0 + 4 * nq) * K + k0 + 8 * ko; t.dj = K; t.db = 64; }
}
__device__ __forceinline__ void tr_load(const TrItem& t, f32x4 (&v)[16]) {
#pragma unroll
    for (int i = 0; i < 16; ++i) v[i] = __builtin_nontemporal_load((const f32x4*)(t.src + (size_t)((i & 7) + 64 * (i >> 3)) * t.N));
}
__device__ __forceinline__ void tr_store(const TrItem& t, const f32x4 (&v)[16]) {
#pragma unroll
    for (int j = 0; j < 4; ++j) {
        u32x4 a, b;
        a.x = pk2(v[0][j], v[1][j]); a.y = pk2(v[2][j], v[3][j]); a.z = pk2(v[4][j], v[5][j]); a.w = pk2(v[6][j], v[7][j]);
        b.x = pk2(v[8][j], v[9][j]); b.y = pk2(v[10][j], v[11][j]); b.z = pk2(v[12][j], v[13][j]); b.w = pk2(v[14][j], v[15][j]);
        *(u32x4*)(t.dst + (size_t)j * t.dj) = a; *(u32x4*)(t.dst + (size_t)j * t.dj + t.db) = b;
    }
}
__device__ __forceinline__ void transpose_item(const float* __restrict__ W, int K, int N, bf16_t* __restrict__ WT, int item, int lane) {
    TrItem t; tr_set<false>(t, W, K, N, WT, item, lane); f32x4 v[16]; tr_load(t, v); tr_store(t, v);
}
constexpr int TR_A = (D / 64) * (AB_COLS / 64), TR_O = (D / 64) * (D / 64), TR_CD = (D / 64) * (CD_COLS / 64), TR_GU1 = (D / 64) * (2048 / 64), TR_DN1 = (DE / 64) * (D / 64);
constexpr int TR_NIT = TR_A + 2 * TR_O + TR_CD + 64 * TR_GU1 + 64 * TR_DN1;
__device__ __forceinline__ void tr_decode(KA a, unsigned char* ws, int it, int lane, TrItem& t) {
    int r = it;
    if (r < TR_A) { tr_set(t, a->in[I_ABIN], D, AB_COLS, (bf16_t*)(ws + WS_WABIN), r, lane); return; } r -= TR_A;
    if (r < TR_O) { tr_set(t, a->in[I_ABOUT], D, D, (bf16_t*)(ws + WS_WOUT), r, lane); return; } r -= TR_O;
    if (r < TR_O) { tr_set(t, a->in[I_CDOUT], D, D, (bf16_t*)(ws + WS_WOUT) + (size_t)D * D, r, lane); return; } r -= TR_O;
    if (r < TR_CD) { tr_set(t, a->in[I_CDIN], D, CD_COLS, (bf16_t*)(ws + WS_WCDIN), r, lane); return; } r -= TR_CD;
    { const int layer = r >= 32 * (TR_GU1 + TR_DN1) ? 1 : 0; r -= layer * 32 * (TR_GU1 + TR_DN1);
      if (r < 32 * TR_GU1) { const int m = layer * 32 + r / TR_GU1; tr_set<true, true>(t, a->in[I_WGU] + (size_t)m * D * 2048, D, 2048, (bf16_t*)(ws + WS_WGU) + (size_t)m * 2048 * D, r % TR_GU1, lane); return; } r -= 32 * TR_GU1;
      { const int m = layer * 32 + r / TR_DN1; tr_set<true, true>(t, a->in[I_WDN] + (size_t)m * DE * D, DE, D, (bf16_t*)(ws + WS_WDN) + (size_t)m * D * DE, r % TR_DN1, lane); } }
}
constexpr int FILL6_PERW = 6, FILL6_B0 = 16;
constexpr int FILL3_PERW = 6, FILL3_B0 = 152;
constexpr int FILL11_PERW = 6, FILL11_B0 = 184;
constexpr int TR_F6 = (256 - FILL6_B0) * 8 * FILL6_PERW, TR_F3 = (256 - FILL3_B0) * 8 * FILL3_PERW, TR_F11 = (256 - FILL11_B0) * 8 * FILL11_PERW, TR_FILL = TR_F6 + TR_F3 + TR_F11;
__device__ __forceinline__ void tr_run(KA a, unsigned char* ws, int it0, int it_end, int stride, int lane) {
    int it = it0;
    if (it < it_end) {
        TrItem tA, tB; f32x4 va[16], vb[16];
        tr_decode(a, ws, it, lane, tA); tr_load(tA, va);
        for (;;) {
            int nx = it + stride; bool hn = nx < it_end;
            if (hn) { tr_decode(a, ws, nx, lane, tB); tr_load(tB, vb); }
            tr_store(tA, va); if (!hn) break; it = nx;
            nx = it + stride; hn = nx < it_end;
            if (hn) { tr_decode(a, ws, nx, lane, tA); tr_load(tA, va); }
            tr_store(tB, vb); if (!hn) break; it = nx;
        }
    }
}
__device__ __forceinline__ void phase_prologue(KA a, int gw, int ngw, int lane) {
    unsigned char* ws = a->ws;
    for (int t = gw; t < 2 * 48 * KSPLIT; t += ngw) {
        const int kc = t % KSPLIT, slab = (t / KSPLIT) % 48, layer = t / (KSPLIT * 48);
        const int n0 = slab * 256 + lane * 4, k0 = kc * (D / KSPLIT);
        const float* w = a->in[I_MODW] + ((size_t)layer * D + k0) * (6 * D) + n0;
        const float cA0 = siluf_(a->in[I_C][k0 + lane]), cA1 = siluf_(a->in[I_C][D + k0 + lane]), cA2 = siluf_(a->in[I_CCTX][k0 + lane]);
        const float cB0 = siluf_(a->in[I_C][k0 + 64 + lane]), cB1 = siluf_(a->in[I_C][D + k0 + 64 + lane]), cB2 = siluf_(a->in[I_CCTX][k0 + 64 + lane]);
        f32x4 acc0 = {0.f, 0.f, 0.f, 0.f}, acc1 = acc0, acc2 = acc0;
#pragma unroll 16
        for (int k = 0; k < 64; ++k) {
            const f32x4 wv = __builtin_nontemporal_load((const f32x4*)(w + (size_t)k * (6 * D)));
            const float c0 = rdl(cA0, k), c1 = rdl(cA1, k), c2 = rdl(cA2, k);
            acc0 += wv * c0; acc1 += wv * c1; acc2 += wv * c2;
        }
#pragma unroll 16
        for (int k = 0; k < 64; ++k) {
            const f32x4 wv = __builtin_nontemporal_load((const f32x4*)(w + (size_t)(64 + k) * (6 * D)));
            const float c0 = rdl(cB0, k), c1 = rdl(cB1, k), c2 = rdl(cB2, k);
            acc0 += wv * c0; acc1 += wv * c1; acc2 += wv * c2;
        }
        float* mp = (float*)(ws + WS_MODP) + ((size_t)(kc * 2 + layer) * 3) * (6 * D) + n0;
        *(f32x4*)mp = acc0; *(f32x4*)(mp + 6 * D) = acc1; *(f32x4*)(mp + 12 * D) = acc2;
    }
    if (ngw == 2048) tr_run(a, ws, gw, TR_NIT - TR_FILL, ngw, lane); else tr_run(a, ws, gw, TR_NIT, ngw, lane);
    for (int it = gw; it < 2 * 32 * 4; it += ngw) { const int layer = it >> 7, e = (it >> 2) & 31, d0 = (it & 3) * 512 + lane * 8; const float* rwp = a->in[I_RW] + ((size_t)layer * D + d0) * NE + e;
        float hi[8], lo[8];
#pragma unroll
        for (int j = 0; j < 8; ++j) { const float w = rwp[(size_t)j * NE]; hi[j] = bflo(pk2(w, 0.f)); lo[j] = w - hi[j]; }
        u32x4 wh, wl; wh.x = pk2(hi[0], hi[1]); wh.y = pk2(hi[2], hi[3]); wh.z = pk2(hi[4], hi[5]); wh.w = pk2(hi[6], hi[7]); wl.x = pk2(lo[0], lo[1]); wl.y = pk2(lo[2], lo[3]); wl.z = pk2(lo[4], lo[5]); wl.w = pk2(lo[6], lo[7]);
        *(u32x4*)((bf16_t*)(ws + WS_RWH) + ((size_t)layer * 32 + e) * D + d0) = wh; *(u32x4*)((bf16_t*)(ws + WS_RWL) + ((size_t)layer * 32 + e) * D + d0) = wl; }
    for (int it = gw; it < 2 * 2 * 8 * 4; it += ngw) { const int m = it >> 2, dir = m >> 4, mat = (m >> 3) & 1, hh = m & 7;
        transpose_item(a->in[mat == 0 ? I_WR : I_WI] + (size_t)(dir * 8 + hh) * 128 * 128, 128, 128, (bf16_t*)(ws + WS_WRT) + (size_t)((dir * 2 + mat) * 8 + hh) * 128 * 128, it & 3, lane); }
    for (int it = gw; it < 128 + 64; it += ngw) {
        const int c0 = lane * 2; float v[2];
        if (it < 128) { const int rip = it >> 6, k1 = it & 63;
#pragma unroll
            for (int j = 0; j < 2; ++j) { const int col = c0 + j, ri = col >> 6, l1 = col & 63; const float fr = (float)((k1 * l1) & 63) * (1.0f / 64.0f);
                v[j] = rip == ri ? __builtin_amdgcn_cosf(fr) : (rip == 0 ? __builtin_amdgcn_sinf(fr) : -__builtin_amdgcn_sinf(fr)); }
            *(unsigned*)((bf16_t*)(ws + WS_FA) + it * 128 + c0) = pk2(v[0], v[1]);
        } else { const int k2 = it - 128;
#pragma unroll
            for (int j = 0; j < 2; ++j) { const int col = c0 + j, ri = col >> 6, l2 = col & 63; const float fr = (float)((k2 * l2) & 63) * (1.0f / 64.0f);
                v[j] = (ri == 0 ? __builtin_amdgcn_cosf(fr) : __builtin_amdgcn_sinf(fr)) * (1.0f / 1024.0f); }
            *(unsigned*)((bf16_t*)(ws + WS_GC) + k2 * 128 + c0) = pk2(v[0], v[1]);
        }
    }
    for (int it = gw; it < 256 + 256; it += ngw) {
        const int c0 = lane * 8; float v[8];
        if (it < 256) { const int k = it;
#pragma unroll
            for (int j = 0; j < 8; ++j) { const int col = c0 + j, l = col & 255; const float fr = (float)((k * l) & 255) * (1.0f / 256.0f);
                v[j] = (col < 256 ? __builtin_amdgcn_cosf(fr) : __builtin_amdgcn_sinf(fr)) * (1.0f / 256.0f); }
            u32x4 w; w.x = pk2(v[0], v[1]); w.y = pk2(v[2], v[3]); w.z = pk2(v[4], v[5]); w.w = pk2(v[6], v[7]);
            *(u32x4*)((bf16_t*)(ws + WS_DLC) + (size_t)k * 512 + c0) = w;
        } else { const int r2 = (it - 256) * 2;
            const int row = r2 + (lane >> 5), cc = (lane & 31) * 8, jj = row & 255;
#pragma unroll
            for (int j = 0; j < 8; ++j) { const float fr = (float)((jj * (cc + j)) & 255) * (1.0f / 256.0f); v[j] = row < 256 ? __builtin_amdgcn_cosf(fr) : -__builtin_amdgcn_sinf(fr); }
            u32x4 w; w.x = pk2(v[0], v[1]); w.y = pk2(v[2], v[3]); w.z = pk2(v[4], v[5]); w.w = pk2(v[6], v[7]);
            *(u32x4*)((bf16_t*)(ws + WS_F256) + (size_t)row * 256 + cc) = w;
        }
    }
}
__device__ __forceinline__ void phase_modfinal(KA a, int gt, int ngt) {
    const float* mp = (const float*)(a->ws + WS_MODP); float* mv = (float*)(a->ws + WS_MODV);
    for (int i = gt; i < 2 * 3 * 6 * D; i += ngt) {
        const int n = i % (6 * D), layer = i / (3 * 6 * D);
        float s = a->in[I_MODB][layer * 6 * D + n];
#pragma unroll
        for (int kc = 0; kc < KSPLIT; ++kc) s += mp[(size_t)kc * (2 * 3 * 6 * D) + i];
        mv[i] = s;
    }
}

struct Row32 { float v[32]; };
__device__ __forceinline__ void load_row_f32(const float* p, int lane, Row32& r) {
#pragma unroll
    for (int j = 0; j < 4; ++j) { const f32x4 a = *(const f32x4*)(p + 8 * lane + 512 * j), b = *(const f32x4*)(p + 8 * lane + 512 * j + 4);
        r.v[8 * j + 0] = a[0]; r.v[8 * j + 1] = a[1]; r.v[8 * j + 2] = a[2]; r.v[8 * j + 3] = a[3]; r.v[8 * j + 4] = b[0]; r.v[8 * j + 5] = b[1]; r.v[8 * j + 6] = b[2]; r.v[8 * j + 7] = b[3]; }
}
__device__ __forceinline__ void store_row_f32(float* p, int lane, const Row32& r) {
#pragma unroll
    for (int j = 0; j < 4; ++j) { *(f32x4*)(p + 8 * lane + 512 * j) = (f32x4){r.v[8 * j], r.v[8 * j + 1], r.v[8 * j + 2], r.v[8 * j + 3]}; *(f32x4*)(p + 8 * lane + 512 * j + 4) = (f32x4){r.v[8 * j + 4], r.v[8 * j + 5], r.v[8 * j + 6], r.v[8 * j + 7]}; }
}
__device__ __forceinline__ void load_row_bf16(const bf16_t* p, int lane, Row32& r) {
#pragma unroll
    for (int j = 0; j < 4; ++j) { const u32x4 w = *(const u32x4*)(p + 8 * lane + 512 * j);
        r.v[8 * j + 0] = bflo(w.x); r.v[8 * j + 1] = bfhi(w.x); r.v[8 * j + 2] = bflo(w.y); r.v[8 * j + 3] = bfhi(w.y); r.v[8 * j + 4] = bflo(w.z); r.v[8 * j + 5] = bfhi(w.z); r.v[8 * j + 6] = bflo(w.w); r.v[8 * j + 7] = bfhi(w.w); }
}
__device__ __forceinline__ void store_row_bf16(bf16_t* p, int lane, const Row32& r) {
#pragma unroll
    for (int j = 0; j < 4; ++j) { u32x4 w; w.x = pk2(r.v[8 * j], r.v[8 * j + 1]); w.y = pk2(r.v[8 * j + 2], r.v[8 * j + 3]); w.z = pk2(r.v[8 * j + 4], r.v[8 * j + 5]); w.w = pk2(r.v[8 * j + 6], r.v[8 * j + 7]); *(u32x4*)(p + 8 * lane + 512 * j) = w; }
}
__device__ __forceinline__ float row_rstd(const Row32& r) { float s = 0.f;
#pragma unroll
    for (int i = 0; i < 32; ++i) s += r.v[i] * r.v[i];
    return rsqrtf(wave_sum(s) * (1.0f / D) + EPS); }
__device__ __forceinline__ void norm_mod(const Row32& x, const float* g, const float* sc, const float* sh, int lane, Row32& hx) {
    const float rs = row_rstd(x); Row32 gg, s1, s0; load_row_f32(g, lane, gg); load_row_f32(sc, lane, s1); load_row_f32(sh, lane, s0);
#pragma unroll
    for (int i = 0; i < 32; ++i) hx.v[i] = x.v[i] * rs * gg.v[i] * (1.0f + s1.v[i]) + s0.v[i];
}
__device__ __forceinline__ void lds_fill(LAS float* dst, const float* src, int n, int tid) { for (int i = tid * 4; i < n; i += NTHR * 4) *(LAS f32x4*)(dst + i) = *(const f32x4*)(src + i); }
__device__ __forceinline__ void load_row_lds(const LAS float* p, int lane, Row32& r) {
#pragma unroll
    for (int j = 0; j < 4; ++j) { const f32x4 a = *(const LAS f32x4*)(p + 8 * lane + 512 * j), b = *(const LAS f32x4*)(p + 8 * lane + 512 * j + 4);
        r.v[8 * j + 0] = a[0]; r.v[8 * j + 1] = a[1]; r.v[8 * j + 2] = a[2]; r.v[8 * j + 3] = a[3]; r.v[8 * j + 4] = b[0]; r.v[8 * j + 5] = b[1]; r.v[8 * j + 6] = b[2]; r.v[8 * j + 7] = b[3]; }
}
__device__ __forceinline__ void norm_mod_l(const Row32& x, const LAS float* g, const LAS float* sc, const LAS float* sh, int lane, Row32& hx) {
    const float rs = row_rstd(x); Row32 gg, s1, s0; load_row_lds(g, lane, gg); load_row_lds(sc, lane, s1); load_row_lds(sh, lane, s0);
#pragma unroll
    for (int i = 0; i < 32; ++i) hx.v[i] = x.v[i] * rs * gg.v[i] * (1.0f + s1.v[i]) + s0.v[i];
}
__device__ __forceinline__ int mod_row(int r) { return r < NLAT ? (r >> 12) : 2; }
__device__ __forceinline__ const float* in_row(KA a, int r) { return r < NLAT ? a->in[I_X] + (size_t)r * D : a->in[I_CTX] + (size_t)(r - NLAT) * D; }

__device__ __forceinline__ void phase_h0(KA a, int gw, int ngw, int lane, int tid, LAS unsigned char* lds) {
    const float* mv = (const float*)(a->ws + WS_MODV); bf16_t* H = (bf16_t*)(a->ws + WS_H);
    LAS float* Lg = (LAS float*)lds; LAS float* Lm = Lg + D;
    __syncthreads();
    lds_fill(Lg, a->in[I_NORMG], D, tid);
    for (int mr = 0; mr < 3; ++mr) lds_fill(Lm + mr * 2 * D, mv + (size_t)mr * 6 * D, 2 * D, tid);
    __syncthreads();
    for (int r = gw; r < NTOK; r += ngw) {
        Row32 x, h; load_row_f32(in_row(a, r), lane, x);
        const LAS float* m = Lm + mod_row(r) * 2 * D;
        norm_mod_l(x, Lg, m + D, m, lane, h);
        store_row_bf16(H + (size_t)r * D, lane, h);
    }
    __syncthreads();
}

constexpr int RA_LD = 2056;
__device__ __forceinline__ void phase_row1(KA a, int layer, int nrows, int bid, int G, int wave, int lane, LAS unsigned char* lds) {
    unsigned char* ws = a->ws;
    const int gw = bid * NWAVES + wave, ngw = G * NWAVES, fr = lane & 15, fq = lane >> 4;
    const float* mv = (const float*)(ws + WS_MODV) + (size_t)layer * 3 * 6 * D; const float* ng = a->in[I_NORMG] + (size_t)layer * 4 * D;
    const bf16_t* O = (const bf16_t*)(ws + WS_O + LOFF(layer)); float* XL = (float*)(ws + WS_XL); bf16_t* H = (bf16_t*)(ws + WS_H2 + LOFF(layer));
    const bf16_t* WH = (const bf16_t*)(ws + WS_RWH) + (size_t)layer * 32 * D; const bf16_t* WL = (const bf16_t*)(ws + WS_RWL) + (size_t)layer * 32 * D; const float* rb = a->in[I_RB] + layer * NE;
    unsigned* cnt = (unsigned*)(ws + WS_CTL) + CW_CNT + 32 * layer * CNT_STRIDE;
    int* toke = (int*)(ws + WS_TOKE + LOFF(layer)); int* tokr = (int*)(ws + WS_TOKR + LOFF(layer)); float* tokp = (float*)(ws + WS_TOKP + LOFF(layer)); int* list = (int*)(ws + WS_LIST + LOFF(layer));
    LAS bf16_t* AH = (LAS bf16_t*)lds; LAS bf16_t* AL = (LAS bf16_t*)(lds + 16 * RA_LD * 2);
    LAS float* part = (LAS float*)lds;
    LAS float* fl = (LAS float*)(lds + 16384);
    LAS int* sel_e = (LAS int*)(lds + 131584); LAS float* sel_p = (LAS float*)(lds + 132224);
    LAS int* sel_l = (LAS int*)(lds + 132864);
    LAS int* hist = (LAS int*)(lds + 133504); LAS int* base = hist + 32;
    __syncthreads();
    if ((int)threadIdx.x < 160) sel_e[threadIdx.x] = -1;
    if ((int)threadIdx.x < 32) hist[threadIdx.x] = 0;
    for (int k0 = 0; bid * NWAVES + k0 * ngw < nrows; k0 += 2) {
        __syncthreads();
#pragma unroll
        for (int q = 0; q < 2; ++q) {
            const int r = gw + (k0 + q) * ngw; LAS bf16_t* ah = AH + (2 * wave + q) * RA_LD; LAS bf16_t* al = AL + (2 * wave + q) * RA_LD;
            if (r < nrows) {
                const float* m = mv + (size_t)mod_row(r) * 6 * D;
                Row32 o, x; load_row_bf16(O + (size_t)r * D, lane, o);
                if (layer == 0) load_row_f32(in_row(a, r), lane, x); else load_row_f32(XL + (size_t)r * D, lane, x);
                { const float rs = row_rstd(o); Row32 g1, ga; load_row_f32(ng + D, lane, g1); load_row_f32(m + 2 * D, lane, ga);
#pragma unroll
                  for (int i = 0; i < 32; ++i) x.v[i] += ga.v[i] * (o.v[i] * rs * g1.v[i]); }
                store_row_f32(XL + (size_t)r * D, lane, x);
                Row32 h; norm_mod(x, ng + 2 * D, m + 4 * D, m + 3 * D, lane, h);
#pragma unroll
                for (int j = 0; j < 4; ++j) { u32x4 wh, wl; float lo[8];
                    wh.x = pk2(h.v[8 * j], h.v[8 * j + 1]); wh.y = pk2(h.v[8 * j + 2], h.v[8 * j + 3]); wh.z = pk2(h.v[8 * j + 4], h.v[8 * j + 5]); wh.w = pk2(h.v[8 * j + 6], h.v[8 * j + 7]);
                    lo[0] = h.v[8 * j] - bflo(wh.x); lo[1] = h.v[8 * j + 1] - bfhi(wh.x); lo[2] = h.v[8 * j + 2] - bflo(wh.y); lo[3] = h.v[8 * j + 3] - bfhi(wh.y);
                    lo[4] = h.v[8 * j + 4] - bflo(wh.z); lo[5] = h.v[8 * j + 5] - bfhi(wh.z); lo[6] = h.v[8 * j + 6] - bflo(wh.w); lo[7] = h.v[8 * j + 7] - bfhi(wh.w);
                    wl.x = pk2(lo[0], lo[1]); wl.y = pk2(lo[2], lo[3]); wl.z = pk2(lo[4], lo[5]); wl.w = pk2(lo[6], lo[7]);
                    *(u32x4*)(H + (size_t)r * D + 8 * lane + 512 * j) = wh;
                    *(LAS u32x4*)(ah + 8 * lane + 512 * j) = wh; *(LAS u32x4*)(al + 8 * lane + 512 * j) = wl; }
            } else {
#pragma unroll
                for (int j = 0; j < 4; ++j) { *(LAS u32x4*)(ah + 8 * lane + 512 * j) = (u32x4){0u, 0u, 0u, 0u}; *(LAS u32x4*)(al + 8 * lane + 512 * j) = (u32x4){0u, 0u, 0u, 0u}; }
            }
        }
        __syncthreads();
        f32x4 acc[2] = {(f32x4){0.f, 0.f, 0.f, 0.f}, (f32x4){0.f, 0.f, 0.f, 0.f}};
#pragma unroll
        for (int hf = 0; hf < 2; ++hf) {
            bf16x8 bh[2][4], bl[2][4];
#pragma unroll
            for (int nt = 0; nt < 2; ++nt)
#pragma unroll
                for (int ks = 0; ks < 4; ++ks) { const size_t off = (size_t)(16 * nt + fr) * D + 256 * wave + 128 * hf + 32 * ks + 8 * fq; bh[nt][ks] = *(const bf16x8*)(WH + off); bl[nt][ks] = *(const bf16x8*)(WL + off); }
#pragma unroll
            for (int ks = 0; ks < 4; ++ks) { const int kk = 256 * wave + 128 * hf + 32 * ks + 8 * fq; const bf16x8 ah8 = *(const LAS bf16x8*)(AH + fr * RA_LD + kk), al8 = *(const LAS bf16x8*)(AL + fr * RA_LD + kk);
#pragma unroll
                for (int nt = 0; nt < 2; ++nt) { acc[nt] = __builtin_amdgcn_mfma_f32_16x16x32_bf16(ah8, bh[nt][ks], acc[nt], 0, 0, 0); acc[nt] = __builtin_amdgcn_mfma_f32_16x16x32_bf16(al8, bh[nt][ks], acc[nt], 0, 0, 0);
                    acc[nt] = __builtin_amdgcn_mfma_f32_16x16x32_bf16(ah8, bl[nt][ks], acc[nt], 0, 0, 0); } }
        }
        __syncthreads();
#pragma unroll
        for (int nt = 0; nt < 2; ++nt)
#pragma unroll
            for (int r4 = 0; r4 < 4; ++r4) part[(wave * 16 + 4 * fq + r4) * 32 + 16 * nt + fr] = acc[nt][r4];
        __syncthreads();
        { const int q = lane >> 5, e = lane & 31, row = 2 * wave + q; float s = rb[e];
#pragma unroll
          for (int w8 = 0; w8 < 8; ++w8) s += part[(w8 * 16 + row) * 32 + e];
          fl[row * 32 + e] = s; }
        asm volatile("s_waitcnt lgkmcnt(0)" ::: "memory");
        { const int q = lane >> 5, r = gw + (k0 + q) * ngw; float lg[NE];
#pragma unroll
          for (int e4 = 0; e4 < 8; ++e4) { const f32x4 v = *(const LAS f32x4*)(fl + (2 * wave + q) * 32 + 4 * e4); lg[4 * e4] = v[0]; lg[4 * e4 + 1] = v[1]; lg[4 * e4 + 2] = v[2]; lg[4 * e4 + 3] = v[3]; }
          unsigned taken = 0u; float tv[4]; int te[4];
#pragma unroll
          for (int k = 0; k < 4; ++k) { float best = -3.0e38f; int bi = 0;
#pragma unroll
              for (int e = 0; e < NE; ++e) { const bool ok = !((taken >> e) & 1u) && lg[e] > best; best = ok ? lg[e] : best; bi = ok ? e : bi; }
              taken |= 1u << bi; tv[k] = best; te[k] = bi; }
          float p[4], ps = 0.f;
#pragma unroll
          for (int k = 0; k < 4; ++k) { p[k] = __expf(tv[k] - tv[0]); ps += p[k]; }
          const float inv = 1.0f / ps; const int sl = lane & 31;
          if (sl < 4 && r < nrows) {
              const int e = sl == 0 ? te[0] : sl == 1 ? te[1] : sl == 2 ? te[2] : te[3];
              const float pp = (sl == 0 ? p[0] : sl == 1 ? p[1] : sl == 2 ? p[2] : p[3]) * inv;
              const int slot = (k0 + q) * 8 + wave; sel_e[slot * 4 + sl] = e; sel_p[slot * 4 + sl] = pp;
          } }
    }
    __syncthreads();
    const int it = threadIdx.x; int my_e = -1;
    if (it < 160) { my_e = sel_e[it]; if (my_e >= 0) sel_l[it] = __hip_atomic_fetch_add(hist + my_e, 1, __ATOMIC_RELAXED, __HIP_MEMORY_SCOPE_WORKGROUP); }
    __syncthreads();
    if (it < 32) { const int h = hist[it]; base[it] = h ? (int)__hip_atomic_fetch_add(cnt + it * CNT_STRIDE, (unsigned)h, __ATOMIC_RELAXED, __HIP_MEMORY_SCOPE_AGENT) : 0; }
    __syncthreads();
    if (it < 160 && my_e >= 0) { const int slot = it >> 2, sl = it & 3, r = bid * NWAVES + (slot & 7) + (slot >> 3) * ngw, rank = base[my_e] + sel_l[it];
        list[my_e * LCAP + rank] = r; toke[r * 4 + sl] = my_e; tokr[r * 4 + sl] = rank; tokp[r * 4 + sl] = sel_p[it]; }
}
__device__ __forceinline__ void moe_tables(KA a, int layer, LAS int* tpre, LAS int* tcnt) {
    __syncthreads();
    if (threadIdx.x < 64) {
        const unsigned* cnt = (const unsigned*)(a->ws + WS_CTL) + CW_CNT + 32 * layer * CNT_STRIDE; const int e = threadIdx.x & 31;
        const int c = (int)__hip_atomic_load(cnt + e * CNT_STRIDE, __ATOMIC_RELAXED, __HIP_MEMORY_SCOPE_AGENT), tl = (c + 255) >> 8; int inc = tl;
#pragma unroll
        for (int o = 1; o < 32; o <<= 1) { const int v = __shfl_up(inc, o, 32); if (e >= o) inc += v; }
        if (threadIdx.x < 32) { tcnt[e] = c; tpre[e] = inc - tl; if (e == 31) tpre[32] = inc; }
    }
    __syncthreads();
}
__device__ __forceinline__ void phase_combine(KA a, int layer, int nrows, int gw, int ngw, int lane, int tid, LAS unsigned char* lds, const LAS int* tpre) {
    unsigned char* ws = a->ws;
    const float* mv = (const float*)(ws + WS_MODV) + (size_t)layer * 3 * 6 * D; const float* ng = a->in[I_NORMG] + (size_t)layer * 4 * D;
    const bf16_t* YS = (const bf16_t*)(ws + WS_YS + LOFF(layer)); float* XL = (float*)(ws + WS_XL); bf16_t* H = (bf16_t*)(ws + WS_H + LOFF(1));
    const int* toke = (const int*)(ws + WS_TOKE + LOFF(layer)); const int* tokr = (const int*)(ws + WS_TOKR + LOFF(layer)); const float* tokp = (const float*)(ws + WS_TOKP + LOFF(layer));
    LAS float* Lg = (LAS float*)lds;
    LAS float* Lga = Lg + 2 * D;
    LAS float* Lm1 = Lga + 3 * D;
    __syncthreads();
    lds_fill(Lg, ng + 3 * D, layer == 0 ? 2 * D : D, tid);
    for (int mr = 0; mr < 3; ++mr) { lds_fill(Lga + mr * D, mv + (size_t)mr * 6 * D + 5 * D, D, tid); if (layer == 0) lds_fill(Lm1 + mr * 2 * D, mv + (size_t)(3 + mr) * 6 * D, 2 * D, tid); }
    __syncthreads();
    for (int r = gw; r < nrows; r += ngw) {
        const int mr = mod_row(r);
        Row32 y;
#pragma unroll
        for (int i = 0; i < 32; ++i) y.v[i] = 0.f;
#pragma unroll
        for (int k = 0; k < 4; ++k) { const int e = toke[r * 4 + k], rk = tokr[r * 4 + k]; const float p = tokp[r * 4 + k]; const int slot = tpre[e] * 256 + rk;
            Row32 t; load_row_bf16(YS + (size_t)slot * D, lane, t);
#pragma unroll
            for (int i = 0; i < 32; ++i) y.v[i] += p * t.v[i]; }
        Row32 x; load_row_f32(XL + (size_t)r * D, lane, x);
        asm volatile("" ::: "memory");
        { const float rs = row_rstd(y); Row32 g3, ga; load_row_lds(Lg, lane, g3); load_row_lds(Lga + mr * D, lane, ga);
#pragma unroll
          for (int i = 0; i < 32; ++i) x.v[i] += ga.v[i] * (y.v[i] * rs * g3.v[i]); }
        if (layer == 1) { store_row_f32(a->out + (size_t)r * D, lane, x); }
        else {
            store_row_f32(XL + (size_t)r * D, lane, x);
            asm volatile("" ::: "memory");
            const LAS float* m1 = Lm1 + mr * 2 * D;
            Row32 h; norm_mod_l(x, Lg + D, m1 + D, m1, lane, h);
            store_row_bf16(H + (size_t)r * D, lane, h);
        }
    }
    __syncthreads();
}

constexpr int XC_LD = 136;
__device__ __forceinline__ void gmlp_stats(KA a, int gw, int ngw, int lane) {
    const bf16_t* PZ = (const bf16_t*)(a->ws + WS_PZ); float* GST = (float*)(a->ws + WS_GST);
    for (int r = gw; r < NTOK; r += ngw) { const bf16_t* vp = PZ + (size_t)r * 2048 + 1024 + lane * 16;
        const u32x4 w0 = *(const u32x4*)vp, w1 = *(const u32x4*)(vp + 8); float x[16];
        x[0] = bflo(w0.x); x[1] = bfhi(w0.x); x[2] = bflo(w0.y); x[3] = bfhi(w0.y); x[4] = bflo(w0.z); x[5] = bfhi(w0.z); x[6] = bflo(w0.w); x[7] = bfhi(w0.w);
        x[8] = bflo(w1.x); x[9] = bfhi(w1.x); x[10] = bflo(w1.y); x[11] = bfhi(w1.y); x[12] = bflo(w1.z); x[13] = bfhi(w1.z); x[14] = bflo(w1.w); x[15] = bfhi(w1.w);
        float s = 0.f;
#pragma unroll
        for (int j = 0; j < 16; ++j) s += x[j];
        const float mu = wave_sum(s) * (1.0f / 1024.0f); float q2 = 0.f;
#pragma unroll
        for (int j = 0; j < 16; ++j) { const float d = x[j] - mu; q2 += d * d; }
        const float rstd = rsqrtf(wave_sum(q2) * (1.0f / 1024.0f) + EPS);
        if (lane == 0) *(f32x2*)(GST + (size_t)r * 2) = (f32x2){mu, rstd}; }
}
__device__ __forceinline__ void gmlp_unit(KA a, LAS unsigned char* lds, int chunk, int hh, int& cur_hh, int tid, int lane, int wave) {
    const bf16_t* PZ = (const bf16_t*)(a->ws + WS_PZ); bf16_t* MIX = (bf16_t*)(a->ws + WS_MIX);
    LAS bf16_t* wsb = (LAS bf16_t*)lds;
    LAS bf16_t* vnT = (LAS bf16_t*)(lds + 34816);
    LAS float* st = (LAS float*)(lds + MISC_OFF + 1024);
    const int r0 = chunk * 128, fr = lane & 15, fq = lane >> 4;
    __syncthreads();
    if (hh != cur_hh) { const float* wsrc = a->in[I_WS] + (size_t)hh * 128 * 128; cur_hh = hh;
        for (int i = tid; i < 128 * 16; i += NTHR) { const int p = i >> 4, c8 = (i & 15) * 8; const f32x4 w0 = *(const f32x4*)(wsrc + p * 128 + c8), w1 = *(const f32x4*)(wsrc + p * 128 + c8 + 4);
            u32x4 o; o.x = pk2(w0[0], w0[1]); o.y = pk2(w0[2], w0[3]); o.z = pk2(w1[0], w1[1]); o.w = pk2(w1[2], w1[3]); *(LAS u32x4*)(wsb + p * XC_LD + c8) = o; } }
    if (tid < 256) st[tid] = ((const float*)(a->ws + WS_GST))[(size_t)r0 * 2 + tid];
    __syncthreads();
    for (int i = tid; i < 64 * 16; i += NTHR) { const int q = (i & 63) * 2, d0 = (i >> 6) * 8;
        const u32x4 w0 = *(const u32x4*)(PZ + (size_t)(r0 + q) * 2048 + 1024 + hh * 128 + d0), w1 = *(const u32x4*)(PZ + (size_t)(r0 + q + 1) * 2048 + 1024 + hh * 128 + d0);
        const float mu0 = st[2 * q], rs0 = st[2 * q + 1], mu1 = st[2 * q + 2], rs1 = st[2 * q + 3]; const float* vg = a->in[I_VG] + hh * 128 + d0;
        const f32x4 g0 = *(const f32x4*)vg, g1 = *(const f32x4*)(vg + 4);
        LAS unsigned* dp = (LAS unsigned*)(vnT + d0 * XC_LD + q);
        dp[0 * (XC_LD / 2)] = pk2((bflo(w0.x) - mu0) * rs0 * g0[0], (bflo(w1.x) - mu1) * rs1 * g0[0]); dp[1 * (XC_LD / 2)] = pk2((bfhi(w0.x) - mu0) * rs0 * g0[1], (bfhi(w1.x) - mu1) * rs1 * g0[1]);
        dp[2 * (XC_LD / 2)] = pk2((bflo(w0.y) - mu0) * rs0 * g0[2], (bflo(w1.y) - mu1) * rs1 * g0[2]); dp[3 * (XC_LD / 2)] = pk2((bfhi(w0.y) - mu0) * rs0 * g0[3], (bfhi(w1.y) - mu1) * rs1 * g0[3]);
        dp[4 * (XC_LD / 2)] = pk2((bflo(w0.z) - mu0) * rs0 * g1[0], (bflo(w1.z) - mu1) * rs1 * g1[0]); dp[5 * (XC_LD / 2)] = pk2((bfhi(w0.z) - mu0) * rs0 * g1[1], (bfhi(w1.z) - mu1) * rs1 * g1[1]);
        dp[6 * (XC_LD / 2)] = pk2((bflo(w0.w) - mu0) * rs0 * g1[2], (bflo(w1.w) - mu1) * rs1 * g1[2]); dp[7 * (XC_LD / 2)] = pk2((bfhi(w0.w) - mu0) * rs0 * g1[3], (bfhi(w1.w) - mu1) * rs1 * g1[3]); }
    __syncthreads();
    const int wm = wave >> 1, wn = wave & 1;
    f32x4 acc[2][4];
#pragma unroll
    for (int m = 0; m < 2; ++m)
#pragma unroll
        for (int n = 0; n < 4; ++n) acc[m][n] = (f32x4){0.f, 0.f, 0.f, 0.f};
#pragma unroll
    for (int ks = 0; ks < 4; ++ks) { bf16x8 xf[2], yf[4];
#pragma unroll
        for (int m = 0; m < 2; ++m) xf[m] = *(const LAS bf16x8*)(wsb + (32 * wm + 16 * m + fr) * XC_LD + 32 * ks + 8 * fq);
#pragma unroll
        for (int n = 0; n < 4; ++n) yf[n] = *(const LAS bf16x8*)(vnT + (64 * wn + 16 * n + fr) * XC_LD + 32 * ks + 8 * fq);
#pragma unroll
        for (int m = 0; m < 2; ++m)
#pragma unroll
            for (int n = 0; n < 4; ++n) acc[m][n] = __builtin_amdgcn_mfma_f32_16x16x32_bf16(yf[n], xf[m], acc[m][n], 0, 0, 0); }
#pragma unroll
    for (int m = 0; m < 2; ++m) { const int p = 32 * wm + 16 * m + fr; const float bias = a->in[I_BS][hh * 128 + p];
#pragma unroll
        for (int n = 0; n < 4; ++n) { const int d0 = 64 * wn + 16 * n + 4 * fq; const u32x2 uu = *(const u32x2*)(PZ + (size_t)(r0 + p) * 2048 + hh * 128 + d0);
            u32x2 o; o.x = pk2(bflo(uu.x) * (acc[m][n][0] + bias), bfhi(uu.x) * (acc[m][n][1] + bias)); o.y = pk2(bflo(uu.y) * (acc[m][n][2] + bias), bfhi(uu.y) * (acc[m][n][3] + bias));
            *(u32x2*)(MIX + (size_t)(r0 + p) * D + 1024 + hh * 128 + d0) = o; } }
}


constexpr int WP_LD = 136;
__device__ __forceinline__ void fft_unit(KA a, LAS unsigned char* lds, int unit, int tid) {
    const int b = unit >> 7, n0 = (unit & 127) * 8;
    const int lane = tid & 63, wave = __builtin_amdgcn_readfirstlane(tid >> 6), fr = lane & 15, fq = lane >> 4, n = n0 + wave;
    const bf16_t* Z = (const bf16_t*)(a->ws + WS_ZT) + (size_t)(b * 1024 + n) * 64 * 128;
    const bf16_t* FA = (const bf16_t*)(a->ws + WS_FA); const bf16_t* GC = (const bf16_t*)(a->ws + WS_GC);
    LAS bf16_t* wp = (LAS bf16_t*)(lds + wave * (64 * WP_LD * 2));
    __syncthreads();
    bf16x8 yf[4][4];
#pragma unroll
    for (int t = 0; t < 4; ++t)
#pragma unroll
        for (int ks = 0; ks < 4; ++ks) yf[t][ks] = *(const bf16x8*)(Z + (size_t)(16 * t + fr) * 128 + 32 * ks + 8 * fq);
#pragma unroll 1
    for (int aa = 0; aa < 4; ++aa) {
        bf16x8 xr[4], xi[4];
#pragma unroll
        for (int ks = 0; ks < 4; ++ks) { xr[ks] = *(const bf16x8*)(FA + (size_t)(16 * aa + fr) * 128 + 32 * ks + 8 * fq); xi[ks] = *(const bf16x8*)(FA + (size_t)(64 + 16 * aa + fr) * 128 + 32 * ks + 8 * fq); }
#pragma unroll
        for (int t = 0; t < 4; ++t) { f32x4 cr = {0.f, 0.f, 0.f, 0.f}, ci = {0.f, 0.f, 0.f, 0.f};
#pragma unroll
            for (int ks = 0; ks < 4; ++ks) { cr = __builtin_amdgcn_mfma_f32_16x16x32_bf16(yf[t][ks], xr[ks], cr, 0, 0, 0); ci = __builtin_amdgcn_mfma_f32_16x16x32_bf16(yf[t][ks], xi[ks], ci, 0, 0, 0); }
            const int k1 = 16 * aa + fr; float wr4[4], wi4[4];
#pragma unroll
            for (int r = 0; r < 4; ++r) { const int l2 = 16 * t + 4 * fq + r; const float ang = (float)(k1 * l2) * (1.0f / 4096.0f), ct = __builtin_amdgcn_cosf(ang), st = __builtin_amdgcn_sinf(ang);
                wr4[r] = cr[r] * ct + ci[r] * st; wi4[r] = ci[r] * ct - cr[r] * st; }
            u32x2 w; w.x = pk2(wr4[0], wr4[1]); w.y = pk2(wr4[2], wr4[3]); *(LAS u32x2*)(wp + k1 * WP_LD + 16 * t + 4 * fq) = w;
            w.x = pk2(wi4[0], wi4[1]); w.y = pk2(wi4[2], wi4[3]); *(LAS u32x2*)(wp + k1 * WP_LD + 64 + 16 * t + 4 * fq) = w; }
    }
    f32x4 yo[4][4];
#pragma unroll
    for (int aa = 0; aa < 4; ++aa)
#pragma unroll
        for (int c = 0; c < 4; ++c) yo[aa][c] = (f32x4){0.f, 0.f, 0.f, 0.f};
#pragma unroll
    for (int ks = 0; ks < 4; ++ks) { bf16x8 gf[4], wf4[4];
#pragma unroll
        for (int c = 0; c < 4; ++c) gf[c] = *(const bf16x8*)(GC + (size_t)(16 * c + fr) * 128 + 32 * ks + 8 * fq);
#pragma unroll
        for (int aa = 0; aa < 4; ++aa) wf4[aa] = *(const LAS bf16x8*)(wp + (16 * aa + fr) * WP_LD + 32 * ks + 8 * fq);
#pragma unroll
        for (int aa = 0; aa < 4; ++aa)
#pragma unroll
            for (int c = 0; c < 4; ++c) yo[aa][c] = __builtin_amdgcn_mfma_f32_16x16x32_bf16(gf[c], wf4[aa], yo[aa][c], 0, 0, 0); }
    __syncthreads();
    LAS bf16_t* ys = (LAS bf16_t*)lds;
#pragma unroll
    for (int aa = 0; aa < 4; ++aa)
#pragma unroll
        for (int c = 0; c < 4; ++c)
#pragma unroll
            for (int r = 0; r < 4; ++r) { const int k = 16 * aa + fr + 64 * (16 * c + 4 * fq + r); ys[k * 8 + wave] = (bf16_t)(pk2(yo[aa][c][r], 0.f) & 0xffffu); }
    __syncthreads();
    bf16_t* MIX = (bf16_t*)(a->ws + WS_MIX);
#pragma unroll
    for (int q = 0; q < 8; ++q) { const int k = tid + q * NTHR; *(u32x4*)(MIX + (size_t)(b * 4096 + k) * D + n0) = *(const LAS u32x4*)(ys + k * 8); }
}
__device__ __forceinline__ void hgrn_rows(int b, int dir, int c, int& rbase, int& rstep) {
    rstep = dir ? -1 : 1;
    if (c == 0) rbase = NLAT + b * CTXL + (dir ? CTXL - 1 : 0); else rbase = b * SEQ + (dir ? SEQ - 1 - (c - 1) * 256 : (c - 1) * 256);
}
constexpr int VT_LD = 264, ST_LD = 136, KE_LD = 40;
__device__ __forceinline__ void hgrn_stage_vT(const bf16_t* V, LAS bf16_t* vT, int rbase, int rstep, int hh, int tid) {
#pragma unroll 2
    for (int idx = tid; idx < 16 * 128; idx += NTHR) { const int s = (idx & 127) * 2, v0 = (idx >> 7) * 8;
        const u32x4 w0 = *(const u32x4*)(V + (size_t)(rbase + rstep * s) * 1024 + hh * 128 + v0), w1 = *(const u32x4*)(V + (size_t)(rbase + rstep * (s + 1)) * 1024 + hh * 128 + v0);
        LAS unsigned* d = (LAS unsigned*)(vT + v0 * VT_LD + s);
        d[0 * (VT_LD / 2)] = (w0.x & 0xffffu) | (w1.x << 16); d[1 * (VT_LD / 2)] = (w0.x >> 16) | (w1.x & 0xffff0000u);
        d[2 * (VT_LD / 2)] = (w0.y & 0xffffu) | (w1.y << 16); d[3 * (VT_LD / 2)] = (w0.y >> 16) | (w1.y & 0xffff0000u);
        d[4 * (VT_LD / 2)] = (w0.z & 0xffffu) | (w1.z << 16); d[5 * (VT_LD / 2)] = (w0.z >> 16) | (w1.z & 0xffff0000u);
        d[6 * (VT_LD / 2)] = (w0.w & 0xffffu) | (w1.w << 16); d[7 * (VT_LD / 2)] = (w0.w >> 16) | (w1.w & 0xffff0000u); }
}
__device__ __forceinline__ void hgrn_A_unit(KA a, LAS unsigned char* lds, int unit, int tid) {
    const int c = unit & 15, chain = unit >> 4, dir = chain & 1, hh = (chain >> 1) & 7, b = chain >> 4;
    const float* LF = (const float*)(a->ws + WS_LF); const bf16_t* V = (const bf16_t*)(a->ws + WS_V);
    float* ST = (float*)(a->ws + WS_ST) + (size_t)(chain * 16 + c) * 128 * 128; float* DT = (float*)(a->ws + WS_DT) + (size_t)(chain * 16 + c) * 128;
    LAS bf16_t* vT = (LAS bf16_t*)lds; LAS bf16_t* kdT = (LAS bf16_t*)(lds + 67584); LAS float* segsum = (LAS float*)(lds + 135168);
    const int lane = tid & 63, wave = __builtin_amdgcn_readfirstlane(tid >> 6), fr = lane & 15, fq = lane >> 4;
    int rbase, rstep; hgrn_rows(b, dir, c, rbase, rstep);
    __syncthreads();
    hgrn_stage_vT(V, vT, rbase, rstep, hh, tid);
    const int kc = tid & 127, seg = tid >> 7;
    const float* lfp = LF + dir * 1024 + hh * 128 + kc;
    float lfv[64]; float ssum = 0.f;
#pragma unroll
    for (int i = 0; i < 64; ++i) { lfv[i] = lfp[(size_t)(rbase + rstep * (seg * 64 + i)) * 2048]; }
#pragma unroll
    for (int i = 0; i < 64; ++i) ssum += lfv[i];
    segsum[seg * 128 + kc] = ssum;
    __syncthreads();
    { const float s0 = segsum[kc], s1 = segsum[128 + kc], s2 = segsum[256 + kc], s3 = segsum[384 + kc];
      const float total = (s0 + s1) + (s2 + s3); float cum = (seg > 0 ? s0 : 0.f) + (seg > 1 ? s1 : 0.f) + (seg > 2 ? s2 : 0.f);
      if (seg == 0) DT[kc] = __expf(total);
#pragma unroll
      for (int i = 0; i < 64; i += 2) { cum += lfv[i]; const float kd0 = (1.0f - __expf(lfv[i])) * __expf(total - cum); cum += lfv[i + 1]; const float kd1 = (1.0f - __expf(lfv[i + 1])) * __expf(total - cum);
          *(LAS unsigned*)(kdT + kc * VT_LD + seg * 64 + i) = pk2(kd0, kd1); } }
    __syncthreads();
    const int wm = wave >> 1, wn = wave & 1;
    f32x4 acc[2][4];
#pragma unroll
    for (int m = 0; m < 2; ++m)
#pragma unroll
        for (int n = 0; n < 4; ++n) acc[m][n] = (f32x4){0.f, 0.f, 0.f, 0.f};
#pragma unroll 2
    for (int ks = 0; ks < 8; ++ks) {
        bf16x8 vf[2], kf[4];
#pragma unroll
        for (int m = 0; m < 2; ++m) vf[m] = *(const LAS bf16x8*)(vT + (32 * wm + 16 * m + fr) * VT_LD + 32 * ks + 8 * fq);
#pragma unroll
        for (int n = 0; n < 4; ++n) kf[n] = *(const LAS bf16x8*)(kdT + (64 * wn + 16 * n + fr) * VT_LD + 32 * ks + 8 * fq);
#pragma unroll
        for (int m = 0; m < 2; ++m)
#pragma unroll
            for (int n = 0; n < 4; ++n) acc[m][n] = __builtin_amdgcn_mfma_f32_16x16x32_bf16(kf[n], vf[m], acc[m][n], 0, 0, 0);
    }
#pragma unroll
    for (int m = 0; m < 2; ++m)
#pragma unroll
        for (int n = 0; n < 4; ++n) *(f32x4*)(ST + (size_t)(32 * wm + 16 * m + fr) * 128 + 64 * wn + 16 * n + 4 * fq) = acc[m][n];
}
__device__ __forceinline__ void hgrn_B(KA a, int gt, int ngt) {
    for (int idx = gt; idx < 32 * 128 * 32; idx += ngt) {
        const int chain = idx >> 12, rem = idx & 4095, vc = rem >> 5, k4 = (rem & 31) * 4;
        const float* stp = (const float*)(a->ws + WS_ST) + ((size_t)chain * 16 * 128 + vc) * 128 + k4; float* st2 = (float*)(a->ws + WS_ST2) + ((size_t)chain * 16 * 128 + vc) * 128 + k4; const float* dtp = (const float*)(a->ws + WS_DT) + (size_t)chain * 16 * 128 + k4;
        f32x4 U[16], Dv[16];
#pragma unroll
        for (int c = 0; c < 16; ++c) { U[c] = *(const f32x4*)(stp + (size_t)c * 128 * 128); Dv[c] = *(const f32x4*)(dtp + c * 128); }
        f32x4 S = {0.f, 0.f, 0.f, 0.f};
#pragma unroll
        for (int c = 0; c < 16; ++c) { S = Dv[c] * S + U[c]; *(f32x4*)(st2 + (size_t)c * 128 * 128) = S; }
    }
}
__device__ __forceinline__ void hgrn_C_unit(KA a, LAS unsigned char* lds, int unit, int tid) {
    const int cl = unit & 15, hh = (unit >> 4) & 7, b = unit >> 7, r0 = b * SEQ + cl * 256;
    const float* LF = (const float*)(a->ws + WS_LF); const bf16_t* V = (const bf16_t*)(a->ws + WS_V); const bf16_t* Q = (const bf16_t*)(a->ws + WS_Q);
    LAS bf16_t* vT = (LAS bf16_t*)lds;
    LAS bf16_t* sT = (LAS bf16_t*)(lds + 67584);
    LAS bf16_t* qd = (LAS bf16_t*)(lds + 102400);
    LAS bf16_t* ki = (LAS bf16_t*)(lds + 111104);
    LAS bf16_t* keT = (LAS bf16_t*)(lds + 119808);
    LAS bf16_t* sc = (LAS bf16_t*)(lds + 130048);
    LAS float* de = (LAS float*)(lds + 132608);
    LAS float* ssq = (LAS float*)(lds + 133120);
    const int lane = tid & 63, wave = __builtin_amdgcn_readfirstlane(tid >> 6), fr = lane & 15, fq = lane >> 4;
    __syncthreads();
    hgrn_stage_vT(V, vT, r0, 1, hh, tid);
    const int kc0 = (wave * 8 + (lane & 7)) * 2, part = lane >> 3;
    f32x4 osum[8][2];
    f32x2 lfN[4]; unsigned qN[4];
#define HC_ISSUE(dirn, jbn) do { _Pragma("unroll") for (int t = 0; t < 4; ++t) { const int row = r0 + 32 * (jbn) + 4 * part + t; \
        lfN[t] = *(const f32x2*)(LF + (size_t)row * 2048 + (dirn) * 1024 + hh * 128 + kc0); qN[t] = *(const unsigned*)(Q + (size_t)row * 1024 + hh * 128 + kc0); } } while (0)
#define HC_BAR() asm volatile("s_waitcnt lgkmcnt(0)\n\ts_barrier" ::: "memory")
    HC_ISSUE(0, 0);
#pragma unroll 1
    for (int dir = 0; dir < 2; ++dir) {
        const int chain = (b * 8 + hh) * 2 + dir, slot = dir ? 15 - cl : cl;
        f32x4 Sacc[8];
        { const float* stp = (const float*)(a->ws + WS_ST2) + ((size_t)(chain * 16 + slot) * 128 + 16 * wave + fr) * 128 + 4 * fq;
#pragma unroll
          for (int n = 0; n < 8; ++n) { Sacc[n] = *(const f32x4*)(stp + 16 * n); u32x2 w; w.x = pk2(Sacc[n][0], Sacc[n][1]); w.y = pk2(Sacc[n][2], Sacc[n][3]); *(LAS u32x2*)(sT + (16 * wave + fr) * ST_LD + 16 * n + 4 * fq) = w; } }
#pragma unroll
        for (int j = 0; j < 8; ++j) {
            const int jb = dir ? 7 - j : j;
            { f32x2 lf[4]; float qx[4], qy[4];
#pragma unroll
              for (int t = 0; t < 4; ++t) { lf[t] = lfN[t]; const unsigned qw = qN[t]; qx[t] = bflo(qw); qy[t] = bfhi(qw); }
              asm volatile("" ::: "memory");
              if (j < 7) HC_ISSUE(dir, dir ? 6 - j : j + 1); else if (dir == 0) HC_ISSUE(1, 7);
              asm volatile("" ::: "memory");
              f32x2 p[4], run = {0.f, 0.f};
#pragma unroll
              for (int t = 0; t < 4; ++t) { run += lf[t]; p[t] = run; }
              f32x2 off = {0.f, 0.f}, total = {0.f, 0.f};
#pragma unroll
              for (int q = 0; q < 8; ++q) { const float sx = __shfl(run.x, (lane & 7) + 8 * q), sy = __shfl(run.y, (lane & 7) + 8 * q); total.x += sx; total.y += sy; if (q < part) { off.x += sx; off.y += sy; } }
              float kex[4], key[4];
#pragma unroll
              for (int t = 0; t < 4; ++t) {
                  const float clx = dir ? total.x - (off.x + p[t].x) + lf[t].x : off.x + p[t].x, cly = dir ? total.y - (off.y + p[t].y) + lf[t].y : off.y + p[t].y;
                  const float kx = 1.0f - __expf(lf[t].x), ky = 1.0f - __expf(lf[t].y); const int i = 4 * part + t;
                  *(LAS unsigned*)(qd + i * ST_LD + kc0) = pk2(qx[t] * __expf(clx), qy[t] * __expf(cly)); *(LAS unsigned*)(ki + i * ST_LD + kc0) = pk2(kx * __expf(-clx), ky * __expf(-cly));
                  kex[t] = kx * __expf(total.x - clx); key[t] = ky * __expf(total.y - cly); }
              { u32x2 w; w.x = pk2(kex[0], kex[1]); w.y = pk2(kex[2], kex[3]); *(LAS u32x2*)(keT + kc0 * KE_LD + 4 * part) = w; w.x = pk2(key[0], key[1]); w.y = pk2(key[2], key[3]); *(LAS u32x2*)(keT + (kc0 + 1) * KE_LD + 4 * part) = w; }
              if (part == 0) *(LAS f32x2*)(de + kc0) = (f32x2){__expf(total.x), __expf(total.y)}; }
            HC_BAR();
            f32x4 o[2] = {(f32x4){0.f, 0.f, 0.f, 0.f}, (f32x4){0.f, 0.f, 0.f, 0.f}};
#pragma unroll
            for (int ks = 0; ks < 4; ++ks) { const bf16x8 sf = *(const LAS bf16x8*)(sT + (16 * wave + fr) * ST_LD + 32 * ks + 8 * fq);
#pragma unroll
                for (int mi = 0; mi < 2; ++mi) { const bf16x8 qf = *(const LAS bf16x8*)(qd + (16 * mi + fr) * ST_LD + 32 * ks + 8 * fq); o[mi] = __builtin_amdgcn_mfma_f32_16x16x32_bf16(sf, qf, o[mi], 0, 0, 0); } }
            if (wave < 4) { const int mi = wave >> 1, ni = wave & 1; f32x4 sa = {0.f, 0.f, 0.f, 0.f};
#pragma unroll
                for (int ks = 0; ks < 4; ++ks) { const bf16x8 kf = *(const LAS bf16x8*)(ki + (16 * ni + fr) * ST_LD + 32 * ks + 8 * fq), qf = *(const LAS bf16x8*)(qd + (16 * mi + fr) * ST_LD + 32 * ks + 8 * fq);
                    sa = __builtin_amdgcn_mfma_f32_16x16x32_bf16(kf, qf, sa, 0, 0, 0); }
                const int ii = 16 * mi + fr, jp = 16 * ni + 4 * fq; u32x2 w;
                const bool k0 = dir ? (jp + 0 >= ii) : (jp + 0 <= ii), k1 = dir ? (jp + 1 >= ii) : (jp + 1 <= ii), k2 = dir ? (jp + 2 >= ii) : (jp + 2 <= ii), k3 = dir ? (jp + 3 >= ii) : (jp + 3 <= ii);
                w.x = pk2(k0 ? sa[0] : 0.f, k1 ? sa[1] : 0.f); w.y = pk2(k2 ? sa[2] : 0.f, k3 ? sa[3] : 0.f);
                *(LAS u32x2*)(sc + ii * KE_LD + jp) = w; }
            HC_BAR();
            { const bf16x8 vf = *(const LAS bf16x8*)(vT + (16 * wave + fr) * VT_LD + 32 * jb + 8 * fq);
#pragma unroll
              for (int mi = 0; mi < 2; ++mi) { const bf16x8 sf2 = *(const LAS bf16x8*)(sc + (16 * mi + fr) * KE_LD + 8 * fq); o[mi] = __builtin_amdgcn_mfma_f32_16x16x32_bf16(vf, sf2, o[mi], 0, 0, 0); }
              if (dir == 0) { osum[j][0] = o[0]; osum[j][1] = o[1]; } else { osum[7 - j][0] += o[0]; osum[7 - j][1] += o[1]; }
#pragma unroll
              for (int n = 0; n < 8; ++n) { const f32x4 d4 = *(const LAS f32x4*)(de + 16 * n + 4 * fq); const bf16x8 kf = *(const LAS bf16x8*)(keT + (16 * n + fr) * KE_LD + 8 * fq);
                  Sacc[n] = Sacc[n] * d4; Sacc[n] = __builtin_amdgcn_mfma_f32_16x16x32_bf16(kf, vf, Sacc[n], 0, 0, 0);
                  u32x2 w; w.x = pk2(Sacc[n][0], Sacc[n][1]); w.y = pk2(Sacc[n][2], Sacc[n][3]); *(LAS u32x2*)(sT + (16 * wave + fr) * ST_LD + 16 * n + 4 * fq) = w; } }
            HC_BAR();
        }
    }
#pragma unroll
    for (int jb = 0; jb < 8; ++jb)
#pragma unroll
        for (int mi = 0; mi < 2; ++mi) { const f32x4 v = osum[jb][mi]; float s = (v[0] * v[0] + v[1] * v[1]) + (v[2] * v[2] + v[3] * v[3]); s += __shfl_xor(s, 16); s += __shfl_xor(s, 32);
            if (fq == 0) ssq[(32 * jb + 16 * mi + fr) * 8 + wave] = s; }
    __syncthreads();
    { const bf16_t* G = (const bf16_t*)(a->ws + WS_G); bf16_t* MIX = (bf16_t*)(a->ws + WS_MIX + LOFF(1)); const int vc0 = hh * 128 + 16 * wave + 4 * fq;
      const f32x4 on = *(const f32x4*)(a->in[I_ONORM] + vc0);
#pragma unroll
      for (int jb = 0; jb < 8; ++jb)
#pragma unroll
          for (int mi = 0; mi < 2; ++mi) { const int t = 32 * jb + 16 * mi + fr; const f32x4 s0 = *(const LAS f32x4*)(ssq + t * 8), s1 = *(const LAS f32x4*)(ssq + t * 8 + 4);
              const float rs = rsqrtf(((s0[0] + s0[1]) + (s0[2] + s0[3]) + (s1[0] + s1[1]) + (s1[2] + s1[3])) * (1.0f / 128.0f) + EPS);
              const u32x2 gw = *(const u32x2*)(G + (size_t)(r0 + t) * 1024 + vc0); const f32x4 v = osum[jb][mi];
              u32x2 w; w.x = pk2(v[0] * rs * on[0] * bflo(gw.x), v[1] * rs * on[1] * bfhi(gw.x)); w.y = pk2(v[2] * rs * on[2] * bflo(gw.y), v[3] * rs * on[3] * bfhi(gw.y));
              *(u32x2*)(MIX + (size_t)(r0 + t) * D + vc0) = w; } }
}
__device__ __forceinline__ int lru_tile(int b, int dir, int p) { return p < 4 ? 128 + 4 * b + (dir ? 3 - p : p) : 64 * b + (dir ? 63 - (p - 4) : p - 4); }
struct LruW { bf16x8 f[2][2][4]; };
__device__ __forceinline__ void lru_A_unit(KA a, LAS unsigned char* lds, int unit, int tid, LruW& wf, int& cur_hh) {
    const int hh = unit & 7, tl = unit >> 3, r0 = tl * 64;
    const bf16_t* LX = (const bf16_t*)(a->ws + WS_LX);
    LAS bf16_t* xcb = (LAS bf16_t*)lds;
    const int lane = tid & 63, wave = __builtin_amdgcn_readfirstlane(tid >> 6), fr = lane & 15, fq = lane >> 4;
    const int seq0 = r0 < NLAT ? (r0 & ~(SEQ - 1)) : NLAT + ((r0 - NLAT) & ~(CTXL - 1)), seqlen = r0 < NLAT ? SEQ : CTXL;
    if (hh != cur_hh) { cur_hh = hh;
#pragma unroll
        for (int dm = 0; dm < 4; ++dm)
#pragma unroll
            for (int ks = 0; ks < 4; ++ks) wf.f[dm >> 1][dm & 1][ks] = *(const bf16x8*)((const bf16_t*)(a->ws + WS_WRT) + ((size_t)(dm * 8 + hh) * 128 + 16 * wave + fr) * 128 + 32 * ks + 8 * fq); }
    __syncthreads();
    {
        const int c = (tid & 63) * 2, t0 = (tid >> 6) * 8, ch2 = hh * 128 + c, pos0 = r0 + t0 - seq0;
        f32x2 cw[4];
#pragma unroll
        for (int jj = 0; jj < 4; ++jj) cw[jj] = *(const f32x2*)(a->in[I_CONVW] + jj * 1024 + ch2);
        const f32x2 cb = *(const f32x2*)(a->in[I_CONVB] + ch2);
        float x0[11], x1[11];
#pragma unroll
        for (int q = 0; q < 11; ++q) { const int p = pos0 + q - 2; unsigned w = 0u; if (p >= 0 && p < seqlen) w = *(const unsigned*)(LX + (size_t)(seq0 + p) * 1024 + ch2); x0[q] = bflo(w); x1[q] = bfhi(w); }
#pragma unroll
        for (int q = 0; q < 8; ++q) { float s0 = cb.x, s1 = cb.y;
#pragma unroll
            for (int jj = 0; jj < 4; ++jj) { s0 += cw[jj].x * x0[q + jj]; s1 += cw[jj].y * x1[q + jj]; }
            *(LAS unsigned*)(xcb + (t0 + q) * XC_LD + c) = pk2(s0, s1); }
    }
    __syncthreads();
    const int j = 16 * wave + fr, ch = hh * 128 + j;
    LAS bf16_t* las = (LAS bf16_t*)(lds + 17408); LAS bf16_t* lus = (LAS bf16_t*)(lds + 33792);
    bf16x8 af[4][4];
#pragma unroll
    for (int ks = 0; ks < 4; ++ks)
#pragma unroll
        for (int m = 0; m < 4; ++m) af[ks][m] = *(const LAS bf16x8*)(xcb + (16 * m + fr) * XC_LD + 32 * ks + 8 * fq);
    float xcv[4][4];
#pragma unroll
    for (int m = 0; m < 4; ++m)
#pragma unroll
        for (int r = 0; r < 4; ++r) xcv[m][r] = bf1(xcb[(16 * m + 4 * fq + r) * XC_LD + j]);
#pragma unroll
    for (int dir = 0; dir < 2; ++dir) {
        f32x4 acc[2][4];
#pragma unroll
        for (int mat = 0; mat < 2; ++mat)
#pragma unroll
            for (int m = 0; m < 4; ++m) { acc[mat][m] = (f32x4){0.f, 0.f, 0.f, 0.f};
#pragma unroll
                for (int ks = 0; ks < 4; ++ks) acc[mat][m] = __builtin_amdgcn_mfma_f32_16x16x32_bf16(af[ks][m], wf.f[dir][mat][ks], acc[mat][m], 0, 0, 0); }
        const float br = a->in[I_BR][dir * 1024 + ch], bi = a->in[I_BI][dir * 1024 + ch]; const float el = __expf(-a->in[I_LAM][dir * 1024 + ch]), sp = el < 0.03f ? el * (1.0f - el * (0.5f - el * (1.0f / 3.0f))) : __logf(1.0f + el);
        float la[4][4], uu[4][4], g[4];
#pragma unroll
        for (int m = 0; m < 4; ++m) { g[m] = 0.f;
#pragma unroll
            for (int r = 0; r < 4; ++r) { const int t = 16 * m + 4 * fq + r; const float rg = sigmoidf_(acc[0][m][r] + br), ig = sigmoidf_(acc[1][m][r] + bi); la[m][r] = -8.0f * rg * sp;
                uu[m][r] = sqrtf(1.0f - __expf(2.0f * la[m][r])) * (ig * xcv[m][r]); g[m] += la[m][r];
                las[t * 128 + j] = (bf16_t)(pk2(la[m][r], 0.f) & 0xffffu); lus[t * 128 + j] = (bf16_t)(pk2(uu[m][r], 0.f) & 0xffffu); } }
        float P = 0.f, X[4];
#pragma unroll
        for (int m = 0; m < 4; ++m) { X[m] = P;
#pragma unroll
            for (int f = 0; f < 4; ++f) { const float gv = __shfl(g[m], fr + 16 * f); if (f < fq) X[m] += gv; P += gv; } }
        float E = 0.f;
#pragma unroll
        for (int m = 0; m < 4; ++m) { float c = X[m];
#pragma unroll
            for (int r = 0; r < 4; ++r) { c += la[m][r]; E += uu[m][r] * __expf(dir == 0 ? (P - c) : (c - la[m][r])); } }
        E += __shfl_xor(E, 16); E += __shfl_xor(E, 32);
        if (fq == 0) { ((float*)(a->ws + WS_PS))[((size_t)dir * 136 + tl) * 1024 + ch] = P; ((float*)(a->ws + WS_ES))[((size_t)dir * 136 + tl) * 1024 + ch] = E; }
        __syncthreads();
        { bf16_t* LA = (bf16_t*)(a->ws + WS_LA) + (size_t)dir * NTOK * 1024; bf16_t* LU = (bf16_t*)(a->ws + WS_LU) + (size_t)dir * NTOK * 1024;
#pragma unroll
          for (int q = 0; q < 2; ++q) { const int i = tid + q * NTHR, t = i >> 4, c8 = (i & 15) * 8;
              *(u32x4*)(LA + (size_t)(r0 + t) * 1024 + hh * 128 + c8) = *(const LAS u32x4*)(las + t * 128 + c8); *(u32x4*)(LU + (size_t)(r0 + t) * 1024 + hh * 128 + c8) = *(const LAS u32x4*)(lus + t * 128 + c8); } }
        if (dir == 0) __syncthreads();
    }
}
__device__ __forceinline__ void lru_B(KA a, int gt) {
    if (gt >= NB * 2 * 1024) return;
    const int ch = gt & 1023, dir = (gt >> 10) & 1, b = gt >> 11;
    const float* PS = (const float*)(a->ws + WS_PS) + (size_t)dir * 136 * 1024 + ch; const float* ES = (const float*)(a->ws + WS_ES) + (size_t)dir * 136 * 1024 + ch;
    float* HI = (float*)(a->ws + WS_HI) + (size_t)dir * 136 * 1024 + ch;
    float h = 0.f;
#pragma unroll 17
    for (int p = 0; p < 68; ++p) { const int tl = lru_tile(b, dir, p); HI[(size_t)tl * 1024] = h; h = __expf(PS[(size_t)tl * 1024]) * h + ES[(size_t)tl * 1024]; }
}
__device__ __forceinline__ void lru_C(KA a, LAS unsigned char* lds, int tid, int bid, int G) {
    const bf16_t* LG = (const bf16_t*)(a->ws + WS_LG); bf16_t* MIX = (bf16_t*)(a->ws + WS_MIX + LOFF(1));
    LAS f32x2* hfs = (LAS f32x2*)lds;
    const int cp = tid & 255, role = tid >> 8;
    for (int item = bid; item < 256; item += G) {
        const int tl = item >> 1, ch = (item & 1) * 512 + 2 * cp, r0 = tl * 64;
        __syncthreads();
        if (role == 0) {
            const bf16_t* la = (const bf16_t*)(a->ws + WS_LA) + (size_t)r0 * 1024 + ch; const bf16_t* lu = (const bf16_t*)(a->ws + WS_LU) + (size_t)r0 * 1024 + ch;
            f32x2 h = *(const f32x2*)((const float*)(a->ws + WS_HI) + (size_t)tl * 1024 + ch);
#pragma unroll 16
            for (int t = 0; t < 64; ++t) { const unsigned wa = *(const unsigned*)la, wu = *(const unsigned*)lu; la += 1024; lu += 1024;
                h.x = __expf(bflo(wa)) * h.x + bflo(wu); h.y = __expf(bfhi(wa)) * h.y + bfhi(wu); hfs[t * 256 + cp] = h; }
            __syncthreads();
        } else {
            const bf16_t* la = (const bf16_t*)(a->ws + WS_LA) + (size_t)(NTOK + r0 + 63) * 1024 + ch; const bf16_t* lu = (const bf16_t*)(a->ws + WS_LU) + (size_t)(NTOK + r0 + 63) * 1024 + ch;
            f32x2 h = *(const f32x2*)((const float*)(a->ws + WS_HI) + (size_t)(136 + tl) * 1024 + ch);
            f32x2 hb[64];
#pragma unroll
            for (int t = 63; t >= 0; --t) { const unsigned wa = *(const unsigned*)la, wu = *(const unsigned*)lu; la -= 1024; lu -= 1024;
                h.x = __expf(bflo(wa)) * h.x + bflo(wu); h.y = __expf(bfhi(wa)) * h.y + bfhi(wu); hb[t] = h; if ((t & 15) == 0) asm volatile("" ::: "memory"); }
            __syncthreads();
            const bf16_t* lg = LG + (size_t)r0 * 1024 + ch; bf16_t* mx = MIX + (size_t)r0 * D + 1024 + ch;
#pragma unroll
            for (int t = 0; t < 64; ++t) { const f32x2 hf = hfs[t * 256 + cp]; const unsigned wg = *(const unsigned*)(lg + (size_t)t * 1024);
                *(unsigned*)(mx + (size_t)t * D) = pk2((hf.x + hb[t].x) * bflo(wg), (hf.y + hb[t].y) * bfhi(wg)); if ((t & 15) == 15) asm volatile("" ::: "memory"); }
        }
    }
}
#ifndef PHMASK
#define PHMASK 0x1FFFFFu
#endif
#define HAS(k) (((PHMASK) >> (k)) & 1u)
#define IN(k) (HAS(k) && lo <= (k) && (k) < hi)
#define SEAM(k) do { if (lo <= (k) && (k) + 1 < hi) xcd_barrier(bar); } while (0)
#define LAUNDER() int tid = wave * 64 + (int)__builtin_amdgcn_mbcnt_hi(~0u, __builtin_amdgcn_mbcnt_lo(~0u, 0u)); asm volatile("" : "+v"(tid)); int G = G0, bid = bid0; asm volatile("" : "+s"(G), "+s"(bid)); const int lane = tid & 63, gt = bid * NTHR + tid, gw = bid * NWAVES + wave, ngw = G * NWAVES, ngt = G * NTHR; (void)lane; (void)gt; (void)gw; (void)ngw; (void)ngt
template <int LAYER>
__device__ __forceinline__ void shared_phases(LAS unsigned char* lds, const int lo, const int hi, const XcdBarrier& bar, LAS int* tpre, LAS int* tcnt, const int wave, const int G0, const int bid0) {
    constexpr int layer = LAYER, sb = LAYER == 0 ? 6 : 15;
    constexpr int nrows = LAYER == 0 ? NTOK : NLAT;
    if (HAS(6) && lo <= sb && sb < hi) {
        LAUNDER(); KA a = get_args(); unsigned char* ws = a->ws;
        pg8::SchedPlain S{(const char*)(ws + WS_MIX + LOFF(layer)), (const char*)(ws + WS_WOUT) + (size_t)layer * D * D * 2, D, D, nrows / 256, D / 256, D, G, bid};
        EpiRaw E{(bf16_t*)(ws + WS_O + LOFF(layer)), D};
        pg8::gemm_phase<EpiRaw, pg8::SchedPlain, false>(lds, S, E, tid);
        if (LAYER == 0 && G == 256 && bid >= FILL6_B0) { const int base = TR_NIT - TR_F6 + (bid - FILL6_B0) * 8 * FILL6_PERW; tr_run(a, ws, base + wave, base + 8 * FILL6_PERW, 8, lane); }
    } SEAM(sb);
    if (HAS(7) && lo <= sb + 1 && sb + 1 < hi) { LAUNDER(); KA a = get_args(); phase_row1(a, layer, nrows, bid, G, wave, lane, lds); __syncthreads(); } SEAM(sb + 1);
    if (HAS(8) && lo <= sb + 2 && sb + 2 < hi) {
        LAUNDER(); KA a = get_args(); unsigned char* ws = a->ws;
        moe_tables(a, layer, tpre, tcnt);
        SchedGU S{(const char*)(ws + WS_H2 + LOFF(layer)), (const char*)(ws + WS_WGU) + (size_t)layer * NE * 2048 * D * 2, (const int*)(ws + WS_LIST + LOFF(layer)), tpre, tcnt, D, 64, G, bid};
        EpiGU E{(bf16_t*)(ws + WS_ACT + LOFF(layer)), a->in[I_BGU] + (size_t)layer * NE * 2048};
        pg8::gemm_phase<EpiGU, SchedGU, true>(lds, S, E, tid);
    } SEAM(sb + 2);
    if (HAS(9) && lo <= sb + 3 && sb + 3 < hi) {
        LAUNDER(); KA a = get_args(); unsigned char* ws = a->ws;
        moe_tables(a, layer, tpre, tcnt);
        SchedDown S{(const char*)(ws + WS_ACT + LOFF(layer)), (const char*)(ws + WS_WDN) + (size_t)layer * NE * D * DE * 2, tpre, tcnt, 64, 64, G, bid};
        EpiDown E{(bf16_t*)(ws + WS_YS + LOFF(layer)), a->in[I_BDN] + (size_t)layer * NE * D};
        pg8::gemm_phase<EpiDown, SchedDown, false>(lds, S, E, tid);
    } SEAM(sb + 3);
    if (HAS(10) && lo <= sb + 4 && sb + 4 < hi) { LAUNDER(); KA a = get_args(); moe_tables(a, layer, tpre, tcnt); phase_combine(a, layer, nrows, gw, ngw, lane, tid, lds, tpre); } SEAM(sb + 4);
}

__global__ void __launch_bounds__(NTHR, 2) fwd(Args args_unused) {
    extern __shared__ __attribute__((aligned(16))) unsigned char smem[];
    LAS unsigned char* lds = (LAS unsigned char*)smem;
    const int tid0 = threadIdx.x, wave = __builtin_amdgcn_readfirstlane(tid0 >> 6);
    const int G0 = gridDim.x, bid0 = blockIdx.x;
    volatile LAS unsigned* MISC = (volatile LAS unsigned*)(lds + MISC_OFF);
    LAS int* tpre = (LAS int*)(lds + MISC_OFF + 64); LAS int* tcnt = (LAS int*)(lds + MISC_OFF + 64 + 256);
    if (tid0 < 4) MISC[tid0] = 0u;
    __syncthreads();
    int lo, hi; XcdBarrier bar;
    { KA a = get_args(); lo = a->ph_lo; hi = a->ph_hi; bar.bar = (unsigned*)(a->ws + WS_CTL) + CW_BAR; bar.x = 0; bar.st = MISC;
      if (hi - lo > 1) bar = xcd_barrier_post((unsigned*)(a->ws + WS_CTL) + CW_BAR, MISC); }
#define SEAM(k) do { if (lo <= (k) && (k) + 1 < hi) xcd_barrier(bar); } while (0)

    if (IN(0)) { LAUNDER(); KA a = get_args(); phase_prologue(a, gw, ngw, lane);    } SEAM(0);
    if (IN(1)) { LAUNDER(); KA a = get_args(); phase_modfinal(a, gt, ngt);    } SEAM(1);
    if (IN(2)) { LAUNDER(); KA a = get_args(); phase_h0(a, gw, ngw, lane, tid, lds);    } SEAM(2);

    if (IN(3)) {
        LAUNDER(); KA a = get_args(); unsigned char* ws = a->ws;
        pg8::SchedPlain S{(const char*)(ws + WS_H), (const char*)(ws + WS_WABIN), D, D, NTOK / 256, AB_COLS / 256, D, G, bid};
        EpiAbIn E{(bf16_t*)(ws + WS_PA), (bf16_t*)(ws + WS_PZ)};
        pg8::gemm_phase<EpiAbIn, pg8::SchedPlain, false>(lds, S, E, tid);
        if (G == 256 && bid >= FILL3_B0) { const int base = TR_NIT - TR_F6 - TR_F3 + (bid - FILL3_B0) * 8 * FILL3_PERW; tr_run(a, ws, base + wave, base + 8 * FILL3_PERW, 8, lane); }
    } SEAM(3);
    if (IN(4)) {
        LAUNDER(); KA a = get_args(); unsigned char* ws = a->ws;
        { SchedChan S{(const char*)(ws + WS_F256), (const char*)(ws + WS_PA), 256, 1024, G, bid}; EpiChan E{(bf16_t*)(ws + WS_ZT)};
          pg8::gemm_phase<EpiChan, SchedChan, false>(lds, S, E, tid); }
        { SchedChanC S{(const char*)(ws + WS_F256), (const char*)(ws + WS_PA), 256, 1024, G, (bid + 16) % G}; EpiChanC E{(bf16_t*)(ws + WS_ZTC)};
          pg8::gemm_phase<EpiChanC, SchedChanC, false>(lds, S, E, tid); }
        gmlp_stats(a, gw, ngw, lane);
        __syncthreads();
    } SEAM(4);
    if (IN(5)) {
        LAUNDER(); KA a = get_args(); unsigned char* ws = a->ws;
        for (int u = bid; u < 256; u += G) fft_unit(a, lds, u, tid);
        __syncthreads();
        { SchedPosC S{(const char*)(ws + WS_DLC), (const char*)(ws + WS_ZTC), 512, 512, G, (bid + 128) % G}; EpiPos E{(bf16_t*)(ws + WS_MIX)};
          pg8::gemm_phase<EpiPos, SchedPosC, false>(lds, S, E, tid); }
        { int cur_hh = -1; for (int u = bid; u < 68 * 8; u += G) gmlp_unit(a, lds, u >> 3, u & 7, cur_hh, tid, lane, wave);
          __syncthreads(); }
    } SEAM(5);

    shared_phases<0>(lds, lo, hi, bar, tpre, tcnt, wave, G0, bid0);
    if (IN(11)) {
        LAUNDER(); KA a = get_args(); unsigned char* ws = a->ws;
        pg8::SchedPlain S{(const char*)(ws + WS_H + LOFF(1)), (const char*)(ws + WS_WCDIN), D, D, NTOK / 256, CD_COLS / 256, D, G, bid};
        EpiCdIn E{(bf16_t*)(ws + WS_Q), (bf16_t*)(ws + WS_V), (bf16_t*)(ws + WS_G), (bf16_t*)(ws + WS_LG), (bf16_t*)(ws + WS_LX), (float*)(ws + WS_LF), a->in[I_LB]};
        pg8::gemm_phase<EpiCdIn, pg8::SchedPlain, false>(lds, S, E, tid);
        if (G == 256 && bid >= FILL11_B0) { const int base = TR_NIT - TR_FILL + (bid - FILL11_B0) * 8 * FILL11_PERW; tr_run(a, ws, base + wave, base + 8 * FILL11_PERW, 8, lane); }
    } SEAM(11);
    if (IN(12)) {
        LAUNDER(); KA a = get_args();
        for (int u = bid; u < 512; u += G) hgrn_A_unit(a, lds, u, tid);
        { LruW wf; int cur_hh = -1; for (int u = bid; u < (NTOK / 64) * 8; u += G) lru_A_unit(a, lds, u, tid, wf, cur_hh); }
        __syncthreads();
    } SEAM(12);
    if (IN(13)) { LAUNDER(); KA a = get_args(); hgrn_B(a, gt, ngt); lru_B(a, gt);    } SEAM(13);
    if (IN(14)) {
        LAUNDER(); KA a = get_args();
        for (int u = bid; u < 256; u += G) hgrn_C_unit(a, lds, u, tid);
        __syncthreads();
        lru_C(a, lds, tid, bid, G);
    } SEAM(14);

    shared_phases<1>(lds, lo, hi, bar, tpre, tcnt, wave, G0, bid0);
#undef IN
#undef SEAM
}

#ifndef N_LAUNCH_MODE
#define N_LAUNCH_MODE 1
#endif
extern "C" void kernel_launch(void* const* d_in, const int* in_sizes, int n_in, void* d_out, int out_size, void* d_ws, size_t ws_size, hipStream_t stream) {
    static int grid = 0;
    if (grid == 0) {
        if (n_in != 29 || out_size != NLAT * D || ws_size < WS_END) { fprintf(stderr, "kernel_launch: unexpected shapes (n_in %d out %d ws %zu need %zu)\n", n_in, out_size, ws_size, (size_t)WS_END); grid = -1; return; }
        int dev = 0, cus = 0, per_cu = 0;
        if (hipGetDevice(&dev) != hipSuccess || hipDeviceGetAttribute(&cus, hipDeviceAttributeMultiprocessorCount, dev) != hipSuccess) { grid = -1; return; }
        if (hipFuncSetAttribute((const void*)fwd, hipFuncAttributeMaxDynamicSharedMemorySize, LDS_BYTES) != hipSuccess) { fprintf(stderr, "kernel_launch: hipFuncSetAttribute failed\n"); grid = -1; return; }
        if (hipOccupancyMaxActiveBlocksPerMultiprocessor(&per_cu, (const void*)fwd, NTHR, LDS_BYTES) != hipSuccess || per_cu < 1) fprintf(stderr, "kernel_launch: occupancy query reports %d\n", per_cu);
        (void)hipGetLastError();
        grid = cus;
    }
    if (grid < 0) return;
    (void)hipMemsetAsync((char*)d_ws + WS_CTL, 0, CTL_BYTES, stream);
    Args a{};
    for (int i = 0; i < 29; ++i) a.in[i] = (const float*)d_in[i];
    a.out = (float*)d_out; a.ws = (unsigned char*)d_ws;
#if N_LAUNCH_MODE == 1
    a.ph_lo = 0; a.ph_hi = NPH;
    hipLaunchKernelGGL(fwd, dim3(grid), dim3(NTHR), LDS_BYTES, stream, a);
#else
    for (int p = 0; p < NPH; ++p) { a.ph_lo = p; a.ph_hi = p + 1; hipLaunchKernelGGL(fwd, dim3(grid), dim3(NTHR), LDS_BYTES, stream, a); }
#endif
    const hipError_t le = hipPeekAtLastError();
    if (le != hipSuccess) fprintf(stderr, "kernel_launch: launch failed: %s\n", hipGetErrorName(le));
}
```
